# Optimizing an MI355X kernel written in HIP

```python
import math
import jax
import jax.numpy as jnp
from jax import lax
import numpy as np

D_MODEL = 1024
BATCH = 1
SEQ = 16384
DEPTH = 4

GRID_W = 64
CTX_LEN = 256
HEAD_DIM = 64
ROPE_BASE = 10000.0
NORM_EPS = 1e-6
NEG_INF = -1e30
Q_BLOCK = 128
DIFF_HEADS = 4
DIFF_WIDTH = DIFF_HEADS * 2 * HEAD_DIM
NA_HEADS = 8
NA_WIDTH = NA_HEADS * HEAD_DIM
NA_MAX_ROWS = 8
NA_COLS = 16
AB_Q_COLS = DIFF_WIDTH + NA_WIDTH
AB_IN = 3 * DIFF_WIDTH + 3 * NA_WIDTH
AB_OUT = DIFF_WIDTH + NA_WIDTH
GQA_HEADS = 16
GQA_KV_HEADS = 4
GQA_GROUP = GQA_HEADS // GQA_KV_HEADS
SWA_WINDOW = 128
C_Q_COLS = GQA_HEADS * HEAD_DIM
C_KV_COLS = GQA_KV_HEADS * HEAD_DIM
C_IN = C_Q_COLS + 2 * C_KV_COLS
FFN_HIDDEN = (8 * D_MODEL + 3 * 256 - 1) // (3 * 256) * 256
N_EVEN = (DEPTH + 1) // 2
N_ODD = DEPTH // 2

kernel_name = "hybrid_diffattn_natten_swa_prefix_trunk"


def rmsnorm(x, g):
    xf = x.astype(jnp.float32)
    y = xf * lax.rsqrt(jnp.mean(xf * xf, axis=-1, keepdims=True) + NORM_EPS)
    return (y * g.astype(jnp.float32)).astype(x.dtype)


def modulate(h, shift, scale):
    return h * (1 + scale) + shift


def swiglu(h, w1, w3, w2):
    return (jax.nn.silu(h @ w1) * (h @ w3)) @ w2


def axial_rope_tables(n, dtype):
    t = jnp.arange(n)
    row = (t // GRID_W).astype(jnp.float32)
    col = (t % GRID_W).astype(jnp.float32)
    quarter = HEAD_DIM // 4
    inv = ROPE_BASE ** (-jnp.arange(quarter, dtype=jnp.float32) / quarter)
    ar = row[:, None] * inv
    ac = col[:, None] * inv
    ang = jnp.concatenate([ar, ar, ac, ac], axis=-1)
    return jnp.cos(ang).astype(dtype), jnp.sin(ang).astype(dtype)


def apply_rope(x, cos, sin):
    xs = x.reshape(x.shape[:-1] + (2, 2, HEAD_DIM // 4))
    rot = jnp.stack([-xs[..., 1, :], xs[..., 0, :]], axis=-2).reshape(x.shape)
    return x * cos[None, :, None, :] + rot * sin[None, :, None, :]


def heads(t, n_heads):
    return t.reshape(t.shape[:2] + (n_heads, -1))


def block_sweep(fn, q):
    B, S = q.shape[:2]
    nb = S // Q_BLOCK
    qb = jnp.moveaxis(q.reshape((B, nb, Q_BLOCK) + q.shape[2:]), 1, 0)
    starts = jnp.arange(nb) * Q_BLOCK
    out = lax.map(lambda a: fn(a[0], a[1]), (qb, starts))
    return jnp.moveaxis(out, 0, 1).reshape((B, S) + out.shape[3:])


def plain_attention(q, k, v):
    s = jnp.einsum('bqhd,bnhd->bhqn', q, k).astype(jnp.float32) * (HEAD_DIM ** -0.5)
    p = jax.nn.softmax(s, axis=-1).astype(v.dtype)
    return jnp.einsum('bhqn,bnhd->bqhd', p, v)


def diff_attend(q, k, v, lam_val):
    B, Q = q.shape[:2]
    s = jnp.einsum('bqhd,bnhd->bhqn', q, k).astype(jnp.float32) * (HEAD_DIM ** -0.5)
    p = jax.nn.softmax(s, axis=-1).reshape(B, DIFF_HEADS, 2, Q, -1)
    p = p[:, :, 0] - lam_val * p[:, :, 1]
    return jnp.einsum('bhqn,bnhd->bqhd', p.astype(v.dtype), v)


def diff_out(a, sub_g, lam_init):
    return (rmsnorm(a, sub_g) * (1.0 - lam_init)).reshape(a.shape[:2] + (-1,))


def neighbourhood_attention(q, k, v, k_c, v_c, rpb):
    B, S, _ = q.shape
    rows = S // GRID_W
    kr = min(NA_MAX_ROWS, rows)
    kc = NA_COLS
    grid = lambda t: t.reshape(B, rows, GRID_W, NA_HEADS, HEAD_DIM)
    qg, kg, vg = grid(q), grid(k), grid(v)
    kcx, vcx = heads(k_c, NA_HEADS), heads(v_c, NA_HEADS)
    col = jnp.arange(GRID_W)
    col_start = jnp.clip(col - kc // 2, 0, GRID_W - kc)
    col_idx = col_start[:, None] + jnp.arange(kc)
    dc_idx = col_idx - col[:, None] + (NA_COLS - 1)
    rpb_cols = rpb[:, :, dc_idx]
    scale = HEAD_DIM ** -0.5

    def row_fn(args):
        q_r, r = args
        rs = jnp.clip(r - kr // 2, 0, rows - kr)
        k_r = lax.dynamic_slice_in_dim(kg, rs, kr, axis=1)[:, :, col_idx]
        v_r = lax.dynamic_slice_in_dim(vg, rs, kr, axis=1)[:, :, col_idx]
        dr_idx = rs + jnp.arange(kr) - r + (NA_MAX_ROWS - 1)
        bias = jnp.transpose(rpb_cols[:, dr_idx], (0, 2, 1, 3))
        s_nb = jnp.einsum('bchd,bicjhd->bhcij', q_r, k_r).astype(jnp.float32) * scale + bias
        s_ctx = jnp.einsum('bchd,bnhd->bhcn', q_r, kcx).astype(jnp.float32) * scale
        s = jnp.concatenate([s_nb.reshape(B, NA_HEADS, GRID_W, kr * kc), s_ctx], axis=-1)
        p = jax.nn.softmax(s, axis=-1).astype(v.dtype)
        p_nb = p[..., :kr * kc].reshape(B, NA_HEADS, GRID_W, kr, kc)
        p_ctx = p[..., kr * kc:]
        return (jnp.einsum('bhcij,bicjhd->bchd', p_nb, v_r)
                + jnp.einsum('bhcn,bnhd->bchd', p_ctx, vcx))

    out = lax.map(row_fn, (jnp.moveaxis(qg, 1, 0), jnp.arange(rows)))
    return jnp.moveaxis(out, 0, 1).reshape(B, S, NA_WIDTH)


def mixer_ab(h_x, h_c, w_in, w_out, lam, sub_g, rpb, lam_init, cos, sin, with_ctx_out):
    B, S, _ = h_x.shape
    n_c = h_c.shape[1]
    cuts = [DIFF_WIDTH, AB_Q_COLS, AB_Q_COLS + DIFF_WIDTH, AB_Q_COLS + 2 * DIFF_WIDTH,
            AB_Q_COLS + 2 * DIFF_WIDTH + NA_WIDTH]
    aq_x, bq_x, ak_x, av_x, bk_x, bv_x = jnp.split(h_x @ w_in, cuts, axis=-1)
    if with_ctx_out:
        p_c = h_c @ w_in
        aq_c, bq_c, kv_c = p_c[..., :DIFF_WIDTH], p_c[..., DIFF_WIDTH:AB_Q_COLS], p_c[..., AB_Q_COLS:]
    else:
        kv_c = h_c @ w_in[:, AB_Q_COLS:]
    ak_c, av_c, bk_c, bv_c = jnp.split(kv_c, [DIFF_WIDTH, 2 * DIFF_WIDTH, 2 * DIFF_WIDTH + NA_WIDTH], axis=-1)

    lf = lam.astype(jnp.float32)
    lam_val = jnp.exp(jnp.sum(lf[0] * lf[1])) - jnp.exp(jnp.sum(lf[2] * lf[3])) + lam_init
    aq_xh = apply_rope(heads(aq_x, 2 * DIFF_HEADS), cos, sin)
    ak_xh = apply_rope(heads(ak_x, 2 * DIFF_HEADS), cos, sin)
    ak_ch, av_ch = heads(ak_c, 2 * DIFF_HEADS), heads(av_c, DIFF_HEADS)
    k_all = jnp.concatenate([ak_ch, ak_xh], axis=1)
    v_all = jnp.concatenate([av_ch, heads(av_x, DIFF_HEADS)], axis=1)
    a_x = block_sweep(lambda qb, start: diff_attend(qb, k_all, v_all, lam_val), aq_xh)
    a_x = diff_out(a_x, sub_g, lam_init)

    b_x = neighbourhood_attention(bq_x, bk_x, bv_x, bk_c, bv_c, rpb)
    out_x = jnp.concatenate([a_x, b_x], axis=-1) @ w_out

    out_c = None
    if with_ctx_out:
        a_c = diff_out(diff_attend(heads(aq_c, 2 * DIFF_HEADS), ak_ch, av_ch, lam_val), sub_g, lam_init)
        b_c = plain_attention(heads(bq_c, NA_HEADS), heads(bk_c, NA_HEADS),
                              heads(bv_c, NA_HEADS)).reshape(B, n_c, NA_WIDTH)
        out_c = jnp.concatenate([a_c, b_c], axis=-1) @ w_out
    return out_x, out_c


def gqa_sink_attend(q, k, v, mask, sinks):
    B, Q = q.shape[:2]
    qg = q.reshape(B, Q, GQA_KV_HEADS, GQA_GROUP, HEAD_DIM)
    s = jnp.einsum('bqkgd,bnkd->bkgqn', qg, k).astype(jnp.float32) * (HEAD_DIM ** -0.5)
    if mask is not None:
        s = jnp.where(mask, s, NEG_INF)
    sink = jnp.broadcast_to(sinks.astype(jnp.float32).reshape(GQA_KV_HEADS, GQA_GROUP, 1, 1),
                            (B, GQA_KV_HEADS, GQA_GROUP, Q, 1))
    p = jax.nn.softmax(jnp.concatenate([s, sink], axis=-1), axis=-1)[..., :-1]
    o = jnp.einsum('bkgqn,bnkd->bqkgd', p.astype(v.dtype), v)
    return o.reshape(B, Q, GQA_HEADS, HEAD_DIM)


def mixer_c(h_x, h_c, w_in, w_out, sinks, cos, sin, with_ctx_out):
    B, S, _ = h_x.shape
    q_x, k_x, v_x = jnp.split(h_x @ w_in, [C_Q_COLS, C_Q_COLS + C_KV_COLS], axis=-1)
    q_x = apply_rope(heads(q_x, GQA_HEADS), cos, sin)
    k_x = apply_rope(heads(k_x, GQA_KV_HEADS), cos, sin)
    v_x = heads(v_x, GQA_KV_HEADS)
    if with_ctx_out:
        p_c = h_c @ w_in
        q_c, kv_c = p_c[..., :C_Q_COLS], p_c[..., C_Q_COLS:]
    else:
        kv_c = h_c @ w_in[:, C_Q_COLS:]
    k_c, v_c = jnp.split(kv_c, 2, axis=-1)
    k_c, v_c = heads(k_c, GQA_KV_HEADS), heads(v_c, GQA_KV_HEADS)
    n_c = k_c.shape[1]

    pad = ((0, 0), (SWA_WINDOW, SWA_WINDOW), (0, 0), (0, 0))
    k_pad, v_pad = jnp.pad(k_x, pad), jnp.pad(v_x, pad)
    span = Q_BLOCK + 2 * SWA_WINDOW
    ctx_mask = jnp.ones((Q_BLOCK, n_c), dtype=bool)

    def blk(q_b, start):
        k_b = lax.dynamic_slice_in_dim(k_pad, start, span, axis=1)
        v_b = lax.dynamic_slice_in_dim(v_pad, start, span, axis=1)
        q_pos = start + jnp.arange(Q_BLOCK)
        k_pos = start - SWA_WINDOW + jnp.arange(span)
        band = ((k_pos >= 0) & (k_pos < S))[None, :] & (jnp.abs(q_pos[:, None] - k_pos[None, :]) <= SWA_WINDOW)
        return gqa_sink_attend(q_b, jnp.concatenate([k_c, k_b], axis=1),
                               jnp.concatenate([v_c, v_b], axis=1),
                               jnp.concatenate([ctx_mask, band], axis=-1), sinks)

    out_x = block_sweep(blk, q_x).reshape(B, S, C_Q_COLS) @ w_out
    out_c = None
    if with_ctx_out:
        o_c = gqa_sink_attend(heads(q_c, GQA_HEADS), k_c, v_c, None, sinks)
        out_c = o_c.reshape(B, n_c, C_Q_COLS) @ w_out
    return out_x, out_c


def setup_inputs(seed: int = 0) -> dict:
    key = jax.random.key(seed)
    ks = jax.random.split(key, 19)
    nrm = lambda k, shape, std: jax.random.normal(k, shape, jnp.float32) * std
    D = D_MODEL
    return {
        'x': nrm(ks[0], (BATCH, SEQ, D), 1.0),
        'c': nrm(ks[1], (BATCH, D), 1.0),
        'ctx': nrm(ks[2], (BATCH, CTX_LEN, D), 1.0),
        'c_ctx': nrm(ks[3], (D,), 1.0),
        'ada_w': nrm(ks[4], (DEPTH, D, 6 * D), 0.5 * D ** -0.5),
        'ada_b': nrm(ks[5], (DEPTH, 6 * D), 0.02),
        'norm_g': 1.0 + nrm(ks[6], (DEPTH, 2, D), 0.01),
        'w_in_ab': nrm(ks[7], (N_EVEN, D, AB_IN), D ** -0.5),
        'w_out_ab': nrm(ks[8], (N_EVEN, AB_OUT, D), AB_OUT ** -0.5),
        'diff_lambda': nrm(ks[9], (N_EVEN, 4, HEAD_DIM), 0.1),
        'diff_sub_g': 1.0 + nrm(ks[10], (N_EVEN, 2 * HEAD_DIM), 0.01),
        'na_rpb': nrm(ks[11], (N_EVEN, NA_HEADS, 2 * NA_MAX_ROWS - 1, 2 * NA_COLS - 1), 0.1),
        'w_in_c': nrm(ks[12], (N_ODD, D, C_IN), D ** -0.5),
        'w_out_c': nrm(ks[13], (N_ODD, C_Q_COLS, D), C_Q_COLS ** -0.5),
        'attn_sinks': nrm(ks[14], (N_ODD, GQA_HEADS), 0.5),
        'ffn_w1': nrm(ks[15], (DEPTH, D, FFN_HIDDEN), D ** -0.5),
        'ffn_w3': nrm(ks[16], (DEPTH, D, FFN_HIDDEN), D ** -0.5),
        'ffn_w2': nrm(ks[17], (DEPTH, FFN_HIDDEN, D), FFN_HIDDEN ** -0.5),
        'final_g': 1.0 + nrm(ks[18], (D,), 0.01),
    }


def reference(x, c, ctx, c_ctx, ada_w, ada_b, norm_g, w_in_ab, w_out_ab, diff_lambda, diff_sub_g,
              na_rpb, w_in_c, w_out_c, attn_sinks, ffn_w1, ffn_w3, ffn_w2, final_g):
    B, S, _ = x.shape
    cos, sin = axial_rope_tables(S, x.dtype)
    for layer in range(DEPTH):
        ctx_out = layer < DEPTH - 1
        mod_x = jnp.split((jax.nn.silu(c) @ ada_w[layer] + ada_b[layer])[:, None, :], 6, axis=-1)
        mod_c = jnp.split(jax.nn.silu(c_ctx) @ ada_w[layer] + ada_b[layer], 6, axis=-1)
        h_x = modulate(rmsnorm(x, norm_g[layer, 0]), mod_x[0], mod_x[1])
        h_c = modulate(rmsnorm(ctx, norm_g[layer, 0]), mod_c[0], mod_c[1])
        if layer % 2 == 0:
            e = layer // 2
            lam_init = 0.8 - 0.6 * math.exp(-0.3 * layer)
            o_x, o_c = mixer_ab(h_x, h_c, w_in_ab[e], w_out_ab[e], diff_lambda[e], diff_sub_g[e],
                                na_rpb[e], lam_init, cos, sin, ctx_out)
        else:
            o = layer // 2
            o_x, o_c = mixer_c(h_x, h_c, w_in_c[o], w_out_c[o], attn_sinks[o], cos, sin, ctx_out)
        x = x + mod_x[2] * o_x
        h_x = modulate(rmsnorm(x, norm_g[layer, 1]), mod_x[3], mod_x[4])
        x = x + mod_x[5] * swiglu(h_x, ffn_w1[layer], ffn_w3[layer], ffn_w2[layer])
        if ctx_out:
            ctx = ctx + mod_c[2] * o_c
            h_c = modulate(rmsnorm(ctx, norm_g[layer, 1]), mod_c[3], mod_c[4])
            ctx = ctx + mod_c[5] * swiglu(h_c, ffn_w1[layer], ffn_w3[layer], ffn_w2[layer])
    return rmsnorm(x, final_g)
```

```cpp
#include <hip/hip_runtime.h>
#include <hip/hip_cooperative_groups.h>
#include <cstdio>
#include <cstdint>
namespace cg = cooperative_groups;
namespace pg8 {
#define PG8_LAS __attribute__((address_space(3)))
typedef unsigned short bf16_t;
typedef short bf16x8 __attribute__((ext_vector_type(8)));
typedef float f32x4 __attribute__((ext_vector_type(4)));
typedef unsigned u32x4 __attribute__((ext_vector_type(4)));
constexpr int BM = 256, BK = 64, HALF = 128, HTB = HALF * BK * 2  , STAGE_BYTES = 8 * HTB, NXCD = 8, WGM = 8;

__host__ __device__ __forceinline__ int lds_byte(int r, int c) { const int st = (r >> 4) * 2 + (c >> 5), rr = r & 15, cc = c & 31, ob = rr * 64 + cc * 2; return st * 1024 + (ob ^ (((ob >> 9) & 1) << 5)); }
__host__ __device__ __forceinline__ void stage_rc(int b, int& R, int& C) { const int st = b / 1024, sb = b % 1024, swz = sb ^ (((sb >> 9) & 1) << 5); R = (st >> 1) * 16 + swz / 64; C = (st & 1) * 32 + (swz % 64) / 2; }
__host__ __device__ __forceinline__ int perm32(int rho) { const int n = rho >> 4, i = rho & 15; return 8 * (i >> 2) + 4 * n + (i & 3); }

struct Unit { int pm, pn, ko; };
struct Gemm { const bf16_t* A; const bf16_t* Bt; int M, N, K, ld; };

struct StaticOrder {
    int nM, nN, nwg, G, c;
    __host__ __device__ void init(int M, int N, int G_, int c_) { nM = M / BM; nN = N / BM; nwg = nM * nN; G = G_; c = c_; }
    __host__ __device__ bool next(int i, Unit& u) const {
        const long L = (long)i * G + c; if (L >= nwg) return false;
        int wgid = (int)L; { const int q = nwg / NXCD, r = nwg % NXCD, xcd = wgid % NXCD, off = wgid / NXCD; wgid = (xcd < r ? xcd * (q + 1) : r * (q + 1) + (xcd - r) * q) + off; }
        const int nig = WGM * nN, gid = wgid / nig, fm = gid * WGM, gsz = (nM - fm) < WGM ? (nM - fm) : WGM;
        u.pm = fm + ((wgid % nig) % gsz); u.pn = (wgid % nig) / gsz; u.ko = 0; return true;
    }
    __device__ __forceinline__ void a_ready(const Unit&) const {}
    __device__ __forceinline__ void done(const Unit&) const {}
};

__device__ __forceinline__ unsigned cvt_pk_bf16(float lo, float hi) { unsigned r; asm volatile("v_cvt_pk_bf16_f32 %0, %1, %2" : "=v"(r) : "v"(lo), "v"(hi)); return r; }
typedef float f32x2 __attribute__((ext_vector_type(2)));
template <class Epi, class Sched, bool ALIGN_EPI = false, bool SP2 = false>
__device__ __forceinline__ void gemm_phase(PG8_LAS unsigned char* lds, const Gemm g, const Sched& S, const Epi& E) {
    int tid_ = threadIdx.x; asm volatile("" : "+v"(tid_));
    const int tid = tid_, wid = __builtin_amdgcn_readfirstlane(tid >> 6), lane = tid & 63, wr = wid >> 2, wc = wid & 3, fr = lane & 15, fq = lane >> 4;
    const int K = g.ld, nt = g.K / BK;
    unsigned voffA[2], voffB[2];
#pragma unroll
    for (int i = 0; i < 2; ++i) { int R, C; stage_rc(tid * 16 + i * 8192, R, C); const int Rb = Epi::PERM ? ((R & ~31) + perm32(R & 31)) : R;
        voffA[i] = (unsigned)(R * K + C) * 2u; voffB[i] = (unsigned)(Rb * K + C) * 2u; }
    const size_t kstep = (size_t)(BK * 2);
    const size_t hstep = (size_t)HALF * K * 2;
    const size_t tstep = 2 * hstep;
    const unsigned ldsw = (unsigned)wid * 1024u;
    const int aoff = lds_byte(wr * 64 + fr, fq * 8), boff = lds_byte(wc * 32 + fr, fq * 8);
#define PG8_SA(b, h) (((b) * 2 + (h)) * HTB)
#define PG8_SB(b, h) ((4 + (b) * 2 + (h)) * HTB)
#define PG8_STAGE(bufoff, gbase, voff) do { _Pragma("unroll") for (int _i = 0; _i < 2; ++_i) \
        __builtin_amdgcn_global_load_lds((const unsigned*)((const char*)(gbase) + (voff)[_i]), (PG8_LAS unsigned*)(lds + (bufoff) + ldsw + _i * 8192), 16, 0, 0); } while (0)
#define PG8_LDA(dst, b, h) do { _Pragma("unroll") for (int m = 0; m < 4; ++m) _Pragma("unroll") for (int k = 0; k < 2; ++k) dst[m][k] = *(const PG8_LAS bf16x8*)(lds + PG8_SA(b, h) + aoff + m * 2048 + k * 1024); } while (0)
#define PG8_LDB(dst, b, h) do { _Pragma("unroll") for (int n = 0; n < 2; ++n) _Pragma("unroll") for (int k = 0; k < 2; ++k) dst[n][k] = *(const PG8_LAS bf16x8*)(lds + PG8_SB(b, h) + boff + n * 2048 + k * 1024); } while (0)
#define PG8_MMA(ai, bj, At, Bt) do { __builtin_amdgcn_s_setprio(1); _Pragma("unroll") for (int m = 0; m < 4; ++m) _Pragma("unroll") for (int n = 0; n < 2; ++n) _Pragma("unroll") for (int k = 0; k < 2; ++k) \
        acc[ai][bj][m][n] = __builtin_amdgcn_mfma_f32_16x16x32_bf16(Bt[n][k], At[m][k], acc[ai][bj][m][n], 0, 0, 0); __builtin_amdgcn_s_setprio(0); } while (0)
#define PG8_WAIT_V(n) asm volatile("s_waitcnt vmcnt(" #n ")" ::: "memory")
#define PG8_WAIT_L(n) asm volatile("s_waitcnt lgkmcnt(" #n ")" ::: "memory")
#define PG8_BAR __builtin_amdgcn_s_barrier()
#define PG8_SCHED __builtin_amdgcn_sched_barrier(0)
    Unit cur, nxt; int ui = 0;
    if (!S.next(0, cur)) return;
    f32x4 acc[2][2][4][2];
#pragma unroll
    for (int a = 0; a < 2; ++a)
#pragma unroll
        for (int b = 0; b < 2; ++b)
#pragma unroll
            for (int m = 0; m < 4; ++m)
#pragma unroll
                for (int n = 0; n < 2; ++n) acc[a][b][m][n] = (f32x4){0.f, 0.f, 0.f, 0.f};
    bf16x8 At[4][2], B0[2][2], B1[2][2];
    const char* cA = (const char*)g.A + (size_t)cur.pm * tstep + (size_t)cur.ko * 2; const char* cB = (const char*)g.Bt + (size_t)cur.pn * tstep + (size_t)cur.ko * 2;
    S.a_ready(cur);
    if constexpr (SP2) {
        PG8_STAGE(PG8_SB(0, 0), cB, voffB); PG8_STAGE(PG8_SB(0, 1), cB + hstep, voffB); PG8_STAGE(PG8_SA(0, 0), cA, voffA); PG8_STAGE(PG8_SA(0, 1), cA + hstep, voffA);
        if (wr == 1) PG8_BAR;
        PG8_WAIT_V(2); PG8_BAR;
        PG8_STAGE(PG8_SB(1, 0), cB + kstep, voffB); PG8_STAGE(PG8_SA(1, 0), cA + kstep, voffA); PG8_STAGE(PG8_SB(1, 1), cB + hstep + kstep, voffB);
        PG8_WAIT_V(6); PG8_BAR;
    } else {
        PG8_STAGE(PG8_SB(0, 0), cB, voffB); PG8_STAGE(PG8_SA(0, 0), cA, voffA); PG8_STAGE(PG8_SB(0, 1), cB + hstep, voffB); PG8_STAGE(PG8_SA(0, 1), cA + hstep, voffA);
        if (wr == 1) PG8_BAR;
        PG8_WAIT_V(4); PG8_BAR;
        PG8_STAGE(PG8_SB(1, 0), cB + kstep, voffB); PG8_STAGE(PG8_SA(1, 0), cA + kstep, voffA); PG8_STAGE(PG8_SB(1, 1), cB + hstep + kstep, voffB);
        PG8_WAIT_V(6); PG8_BAR;
    }
    for (;;) {
        const bool has_next = S.next(ui + 1, nxt);
        const char* nA = has_next ? (const char*)g.A + (size_t)nxt.pm * tstep + (size_t)nxt.ko * 2 : cA; const char* nB = has_next ? (const char*)g.Bt + (size_t)nxt.pn * tstep + (size_t)nxt.ko * 2 : cB;
        for (int t = 0; t < nt; t += 2) {
            const bool last = (t == nt - 2);
            const char* a1 = cA + (size_t)(t + 1) * kstep;
            const char* a2 = last ? nA : cA + (size_t)(t + 2) * kstep; const char* b2 = last ? nB : cB + (size_t)(t + 2) * kstep;
            const char* a3 = a2 + kstep; const char* b3 = b2 + kstep;
            if (last && has_next) S.a_ready(nxt);
            if constexpr (SP2) {
            PG8_LDB(B0, 0, 0); PG8_LDB(B1, 0, 1); PG8_SCHED; PG8_LDA(At, 0, 0); PG8_STAGE(PG8_SA(1, 1), a1 + hstep, voffA);
            PG8_WAIT_V(8); PG8_WAIT_L(0); PG8_BAR; PG8_MMA(0, 0, At, B0); PG8_MMA(0, 1, At, B1); PG8_BAR; PG8_SCHED;
            PG8_LDA(At, 0, 1); PG8_STAGE(PG8_SB(0, 0), b2, voffB); PG8_STAGE(PG8_SB(0, 1), b2 + hstep, voffB); PG8_STAGE(PG8_SA(0, 0), a2, voffA);
            PG8_WAIT_V(8); PG8_WAIT_L(0); PG8_BAR; PG8_MMA(1, 0, At, B0); PG8_MMA(1, 1, At, B1); PG8_BAR; PG8_SCHED;
            PG8_LDB(B0, 1, 0); PG8_LDB(B1, 1, 1); PG8_SCHED; PG8_LDA(At, 1, 0); PG8_STAGE(PG8_SA(0, 1), a2 + hstep, voffA);
            PG8_WAIT_V(8); PG8_WAIT_L(0); PG8_BAR; PG8_MMA(0, 0, At, B0); PG8_MMA(0, 1, At, B1); PG8_BAR; PG8_SCHED;
            PG8_LDA(At, 1, 1); PG8_STAGE(PG8_SB(1, 0), b3, voffB); PG8_STAGE(PG8_SB(1, 1), b3 + hstep, voffB); PG8_STAGE(PG8_SA(1, 0), a3, voffA);
            PG8_WAIT_V(8); PG8_WAIT_L(0); PG8_BAR; PG8_MMA(1, 0, At, B0); PG8_MMA(1, 1, At, B1); PG8_BAR; PG8_SCHED;
            } else {
            PG8_LDB(B0, 0, 0); PG8_SCHED; PG8_LDA(At, 0, 0); PG8_STAGE(PG8_SA(1, 1), a1 + hstep, voffA);
            PG8_WAIT_L(8); PG8_BAR; PG8_WAIT_L(0); PG8_MMA(0, 0, At, B0); PG8_BAR; PG8_SCHED;
            PG8_LDB(B1, 0, 1); PG8_STAGE(PG8_SB(0, 0), b2, voffB);
            PG8_BAR; PG8_WAIT_L(0); PG8_MMA(0, 1, At, B1); PG8_BAR;
            PG8_LDA(At, 0, 1); PG8_STAGE(PG8_SA(0, 0), a2, voffA);
            PG8_BAR; PG8_WAIT_L(0); PG8_MMA(1, 0, At, B0); PG8_BAR; PG8_SCHED;
            PG8_STAGE(PG8_SB(0, 1), b2 + hstep, voffB);
            PG8_WAIT_V(6); PG8_BAR; PG8_MMA(1, 1, At, B1); PG8_BAR;
            PG8_LDB(B0, 1, 0); PG8_SCHED; PG8_LDA(At, 1, 0); PG8_STAGE(PG8_SA(0, 1), a2 + hstep, voffA);
            PG8_WAIT_L(8); PG8_BAR; PG8_WAIT_L(0); PG8_MMA(0, 0, At, B0); PG8_BAR; PG8_SCHED;
            PG8_LDB(B1, 1, 1); PG8_STAGE(PG8_SB(1, 0), b3, voffB);
            PG8_BAR; PG8_WAIT_L(0); PG8_MMA(0, 1, At, B1); PG8_BAR;
            PG8_LDA(At, 1, 1); PG8_STAGE(PG8_SA(1, 0), a3, voffA);
            PG8_BAR; PG8_WAIT_L(0); PG8_MMA(1, 0, At, B0); PG8_BAR; PG8_SCHED;
            PG8_STAGE(PG8_SB(1, 1), b3 + hstep, voffB);
            PG8_WAIT_V(6); PG8_BAR; PG8_MMA(1, 1, At, B1); PG8_BAR;
            }
        }
        if constexpr (ALIGN_EPI) { if (wr == 0) PG8_BAR; }
        if constexpr (!Epi::AFTER_DRAIN) { E(acc, cur, wr, wc, fr, fq); S.done(cur); }
        if (!has_next) break;
#pragma unroll
        for (int a = 0; a < 2; ++a)
#pragma unroll
            for (int b = 0; b < 2; ++b)
#pragma unroll
                for (int m = 0; m < 4; ++m)
#pragma unroll
                    for (int n = 0; n < 2; ++n) acc[a][b][m][n] = (f32x4){0.f, 0.f, 0.f, 0.f};
        cur = nxt; cA = nA; cB = nB; ++ui;
        if constexpr (ALIGN_EPI) { if (wr == 1) PG8_BAR; }
    }
    PG8_WAIT_V(0);
    if constexpr (!ALIGN_EPI) { if (wr == 0) PG8_BAR; }
    PG8_BAR;
    if constexpr (Epi::AFTER_DRAIN) { E.fused(acc, cur, wr, wc, fr, fq, lds, wid, lane); S.done(cur); }
#undef PG8_SA
#undef PG8_SB
#undef PG8_STAGE
#undef PG8_LDA
#undef PG8_LDB
#undef PG8_MMA
#undef PG8_WAIT_V
#undef PG8_WAIT_L
#undef PG8_BAR
#undef PG8_SCHED
}
}

using pg8::bf16_t; using pg8::bf16x8; using pg8::f32x4; using pg8::u32x4;
#define LAS __attribute__((address_space(3)))
#define DI __device__ __forceinline__
#define GAS __attribute__((address_space(1)))
#define G1(p) ((GAS __typeof__(*(p))*)(p))
typedef float f32x16 __attribute__((ext_vector_type(16)));
typedef unsigned u32x2 __attribute__((ext_vector_type(2)));
typedef short s16x4 __attribute__((ext_vector_type(4)));
typedef __bf16 bf16v2 __attribute__((ext_vector_type(2)));
typedef float f32v2 __attribute__((ext_vector_type(2)));
#define MFMA32(a, b, c) __builtin_amdgcn_mfma_f32_32x32x16_bf16((a), (b), (c), 0, 0, 0)

constexpr int D = 1024, SEQ = 16384, NCTX = 256, T = SEQ + NCTX, DEPTH = 4, FFN = 2816, FFN2 = 2 * FFN, TP = T;
constexpr int NWAVES = 8, NTHR = 512;
constexpr float NORM_EPS = 1e-6f, LOG2E = 1.4426950408889634f, QSCALE = 0.125f * LOG2E, NEGBIG = -1e30f;
constexpr int LDS_BYTES = 135168, LDS_MISC = 132096;

constexpr size_t MiB = 1u << 20;
constexpr size_t WS_ROPE = 0, WS_LAM = 64 * 1024, WS_MOD = 128 * 1024, WS_BAR = 512 * 1024, BAR_ZERO_BYTES = 32768, WS_ZERO = WS_BAR + 16384;
constexpr size_t WS_WINAB = 1 * MiB, WS_WOUTAB = 13 * MiB, WS_WINC = 17 * MiB, WS_WOUTC = 23 * MiB, WS_W13 = 27 * MiB, WS_W2 = 71 * MiB;
constexpr size_t WS_X = 93 * MiB, WS_H = 158 * MiB, WS_AO = 191 * MiB, WS_QK = 224 * MiB, WS_VT = 289 * MiB, WS_HID = 224 * MiB, WS_TMP = 322 * MiB, WS_END = 354 * MiB;

struct Args { const float* in[19]; float* out; unsigned char* ws; int ph_lo, ph_hi; };

DI unsigned pk_bf16(float a, float b) { f32v2 v = {a, b}; bf16v2 r = __builtin_convertvector(v, bf16v2); return __builtin_bit_cast(unsigned, r); }
#define dpp_f(v, ctrl) __builtin_bit_cast(float, __builtin_amdgcn_mov_dpp(__builtin_bit_cast(int, (v)), (ctrl), 0xF, 0xF, true))
DI int opaque_tid() { int t = threadIdx.x; asm volatile("" : "+v"(t)); return t; }
DI float xhalf_max(float v) {
    float a = v, b = v;
    asm volatile("s_nop 1\n\tv_permlane32_swap_b32 %0, %1" : "+v"(a), "+v"(b));
    return fmaxf(a, b); }
DI float fast_exp2(float x) { return __builtin_amdgcn_exp2f(x); }
DI float wave_sum(float v) {
    v += dpp_f(v, 0xB1);
    v += dpp_f(v, 0x4E);
    v += dpp_f(v, 0x124);
    v += dpp_f(v, 0x128);
    float a = v, b = v; asm volatile("s_nop 1\n\tv_permlane16_swap_b32 %0, %1" : "+v"(a), "+v"(b)); v = a + b;
    a = v; b = v; asm volatile("s_nop 1\n\tv_permlane32_swap_b32 %0, %1" : "+v"(a), "+v"(b)); return a + b; }

struct EpiQKV {
    static constexpr bool PERM = false, AFTER_DRAIN = false;
    bf16_t* QK; int ldqk; bf16_t* Vt; int nq, nrow; const f32v2* rope; unsigned rope_mask;
    DI void operator()(const f32x4 (&acc)[2][2][4][2], const pg8::Unit& u, int wr, int wc, int fr, int fq) const {
        if (u.pn < nrow) {
            const float sc = (u.pn < nq) ? QSCALE : 1.f;
            const bool do_rope = (u.pm < 64) && ((rope_mask >> u.pn) & 1u);
#pragma unroll
            for (int ai = 0; ai < 2; ++ai)
#pragma unroll
                for (int m = 0; m < 4; ++m) {
                    const int row = u.pm * 256 + ai * 128 + wr * 64 + m * 16 + fr;
                    f32x4 cc = {1.f, 1.f, 1.f, 1.f}, ss = {0.f, 0.f, 0.f, 0.f};
                    if (do_rope) {
                        const int pos = (wc & 1) ? (row & 63) : (row >> 6);
                        const f32x4* rp = (const f32x4*)(rope + pos * 16 + 4 * fq);
                        const f32x4 t0 = G1(rp)[0], t1 = G1(rp)[1];
                        cc = (f32x4){t0[0], t0[2], t1[0], t1[2]}; ss = (f32x4){t0[1], t0[3], t1[1], t1[3]};
                    }
#pragma unroll
                    for (int bj = 0; bj < 2; ++bj) {
                        const f32x4 x0 = acc[ai][bj][m][0], x1 = acc[ai][bj][m][1];
                        const f32x4 o0 = (x0 * cc - x1 * ss) * sc, o1 = (x1 * cc + x0 * ss) * sc;
                        bf16_t* p = QK + (size_t)row * ldqk + u.pn * 256 + bj * 128 + wc * 32 + 4 * fq;
                        u32x2 w0, w1; w0.x = pk_bf16(o0[0], o0[1]); w0.y = pk_bf16(o0[2], o0[3]); w1.x = pk_bf16(o1[0], o1[1]); w1.y = pk_bf16(o1[2], o1[3]);
                        *G1((u32x2*)p) = w0; *G1((u32x2*)(p + 16)) = w1;
                    }
                }
        } else {
            const int vr0 = (u.pn - nrow) * 256 + wc * 32 + 4 * fq;
#pragma unroll
            for (int ai = 0; ai < 2; ++ai)
#pragma unroll
                for (int m = 0; m < 4; ++m) {
                    const int row = u.pm * 256 + ai * 128 + wr * 64 + m * 16 + fr;
#pragma unroll
                    for (int bj = 0; bj < 2; ++bj)
#pragma unroll
                        for (int n = 0; n < 2; ++n) {
                            const f32x4 v = acc[ai][bj][m][n];
                            bf16_t* p = Vt + (size_t)(vr0 + bj * 128 + n * 16) * TP + row;
                            const unsigned a = pk_bf16(v[0], v[1]), b = pk_bf16(v[2], v[3]);
                            G1(p)[0] = (bf16_t)(a & 0xffffu); G1(p)[TP] = (bf16_t)(a >> 16); G1(p)[2 * (size_t)TP] = (bf16_t)(b & 0xffffu); G1(p)[3 * (size_t)TP] = (bf16_t)(b >> 16);
                        }
                }
        }
    }
};
struct EpiResid {
    static constexpr bool PERM = false, AFTER_DRAIN = false;
    float* X; const float* gate_x; const float* gate_c; const float* Xin;
    DI void operator()(const f32x4 (&acc)[2][2][4][2], const pg8::Unit& u, int wr, int wc, int fr, int fq) const {
        const float* gate = (u.pm < 64) ? gate_x : gate_c;
        const int col0 = u.pn * 256 + wc * 32 + 4 * fq;
#pragma unroll
        for (int ai = 0; ai < 2; ++ai)
#pragma unroll
            for (int m = 0; m < 4; ++m) {
                float* xr = X + (size_t)(u.pm * 256 + ai * 128 + wr * 64 + m * 16 + fr) * D + col0;
                const float* xi = Xin + (size_t)(u.pm * 256 + ai * 128 + wr * 64 + m * 16 + fr) * D + col0;
#pragma unroll
                for (int bj = 0; bj < 2; ++bj)
#pragma unroll
                    for (int n = 0; n < 2; ++n) { const f32x4 gv = *G1((const f32x4*)(gate + col0 + bj * 128 + n * 16)); *G1((f32x4*)(xr + bj * 128 + n * 16)) = *G1((const f32x4*)(xi + bj * 128 + n * 16)) + gv * acc[ai][bj][m][n]; }
                if (m & 1) asm volatile("" ::: "memory");
            }
    }
};
struct EpiPartial {
    static constexpr bool PERM = false, AFTER_DRAIN = false;
    float* part; const float* gate;
    DI void operator()(const f32x4 (&acc)[2][2][4][2], const pg8::Unit& u, int wr, int wc, int fr, int fq) const {
        const int col0 = u.pn * 256 + wc * 32 + 4 * fq;
        float* pb = part + (size_t)(u.ko >> 8) * (NCTX * D);
#pragma unroll
        for (int ai = 0; ai < 2; ++ai)
#pragma unroll
            for (int m = 0; m < 4; ++m) {
                float* xr = pb + (size_t)(ai * 128 + wr * 64 + m * 16 + fr) * D + col0;
#pragma unroll
                for (int bj = 0; bj < 2; ++bj)
#pragma unroll
                    for (int n = 0; n < 2; ++n) { const f32x4 gv = *G1((const f32x4*)(gate + col0 + bj * 128 + n * 16)); *G1((f32x4*)(xr + bj * 128 + n * 16)) = gv * acc[ai][bj][m][n]; }
                asm volatile("" ::: "memory");
            }
    }
};
struct CtxSplit {
    int nsplit, c;
    DI bool next(int i, pg8::Unit& u) const { if (i != 0 || c >= 4 * nsplit) return false; u.pm = 0; u.pn = c & 3; u.ko = (c >> 2) * 256; return true; }
    DI void a_ready(const pg8::Unit&) const {}
    DI void done(const pg8::Unit&) const {}
};
struct EpiSwiGLU {
    static constexpr bool PERM = false, AFTER_DRAIN = false;
    bf16_t* HID;
    DI void operator()(const f32x4 (&acc)[2][2][4][2], const pg8::Unit& u, int wr, int wc, int fr, int fq) const {
#pragma unroll
        for (int ai = 0; ai < 2; ++ai)
#pragma unroll
            for (int m = 0; m < 4; ++m) {
                bf16_t* hr = HID + (size_t)(u.pm * 256 + ai * 128 + wr * 64 + m * 16 + fr) * FFN + (u.pn * 256 + wc * 32) / 2 + 4 * fq;
#pragma unroll
                for (int bj = 0; bj < 2; ++bj) {
                    const f32x4 a = acc[ai][bj][m][0], b = acc[ai][bj][m][1]; f32x4 h;
#pragma unroll
                    for (int e = 0; e < 4; ++e) h[e] = a[e] * __builtin_amdgcn_rcpf(1.f + __expf(-a[e])) * b[e];
                    u32x2 w; w.x = pk_bf16(h[0], h[1]); w.y = pk_bf16(h[2], h[3]);
                    *G1((u32x2*)(hr + bj * 64)) = w;
                }
            }
    }
};

constexpr int AT_KB = 64 * 144, AT_VB = 128 * 144, AT_RPB = 2 * AT_KB + 2 * AT_VB;
static_assert(AT_RPB + 2048 <= LDS_BYTES, "attention LDS");

template <int DV, int MODE>
DI void attn_run(LAS unsigned char* lds, const bf16_t* QK, int ldqk, int qcol, int kcol, const bf16_t* Vt, int q0, int kt0, int kt1,
                 float minit, float linit, f32x16 (&o)[DV / 32], float& m_out, float& l_out) {
    const int tid = opaque_tid(), lane = tid & 63, wid = __builtin_amdgcn_readfirstlane(tid >> 6), r32 = lane & 31, hi = lane >> 5;
    const int qtok = q0 + 32 * wid + r32;
    bf16x8 qf[4];
#pragma unroll
    for (int kk = 0; kk < 4; ++kk) qf[kk] = *G1((const bf16x8*)(QK + (size_t)qtok * ldqk + qcol + 16 * kk + 8 * hi));
#pragma unroll
    for (int d = 0; d < DV / 32; ++d)
#pragma unroll
        for (int i = 0; i < 16; ++i) o[d][i] = 0.f;
    float m_ref = (linit != 0.f) ? minit : 0.f, m_run = (linit != 0.f) ? 0.f : NEGBIG, l = (hi == 0) ? linit : 0.f;
    f32x16 negm;
#pragma unroll
    for (int i = 0; i < 16; ++i) negm[i] = -m_ref;
    asm volatile("" : "+v"(negm));
    const int ntiles = 4 + (kt1 - kt0);
    const int srow = tid >> 3, sch = tid & 7;
    const int qr = (q0 >> 6) + (wid >> 1), qc = 32 * (wid & 1) + r32;
    u32x4 kreg, vreg[DV / 64];
#define AT_TOK(j) ((j) < 4 ? SEQ + 64 * (j) : 64 * (kt0 + (j) - 4))
#define AT_LOAD(j) do { const int tk_ = AT_TOK(j); kreg = *G1((const u32x4*)(QK + (size_t)(tk_ + srow) * ldqk + kcol + sch * 8)); \
        _Pragma("unroll") for (int v_ = 0; v_ < DV / 64; ++v_) vreg[v_] = *G1((const u32x4*)(Vt + (size_t)(srow + 64 * v_) * TP + tk_ + sch * 8)); } while (0)
#define AT_STORE(b) do { *(LAS u32x4*)(lds + (b) * AT_KB + srow * 144 + sch * 16) = kreg; \
        _Pragma("unroll") for (int v_ = 0; v_ < DV / 64; ++v_) { LAS unsigned char* p_ = lds + 2 * AT_KB + (b) * AT_VB + (srow + 64 * v_) * 144 + (sch >> 1) * 32 + (sch & 1) * 8; \
            *(LAS u32x2*)p_ = (u32x2){vreg[v_].x, vreg[v_].y}; *(LAS u32x2*)(p_ + 16) = (u32x2){vreg[v_].z, vreg[v_].w}; } } while (0)
    AT_LOAD(0);
    AT_STORE(0);
    __syncthreads();
    for (int j = 0; j < ntiles; ++j) {
        const int b = j & 1;
        if (j + 1 < ntiles) AT_LOAD(j + 1);
        const int tok0 = AT_TOK(j); const bool lat = j >= 4;
        bool active = true;
        if (MODE == 1 && lat) { const int kr = tok0 >> 6; const int rs = min(max(qr - 4, 0), 248); active = (kr >= rs) && (kr <= rs + 7); }
        if (MODE == 2 && lat) { const int wq0 = q0 + 32 * wid; active = (tok0 + 63 >= wq0 - 128) && (tok0 <= wq0 + 31 + 128); }
        if (active) {
            const LAS unsigned char* Kb = lds + b * AT_KB; const LAS unsigned char* Vb = lds + 2 * AT_KB + b * AT_VB;
            f32x16 st[2];
            {
                bf16x8 kf[2][4];
#pragma unroll
                for (int kb = 0; kb < 2; ++kb)
#pragma unroll
                    for (int kk = 0; kk < 4; ++kk) kf[kb][kk] = *(const LAS bf16x8*)(Kb + (32 * kb + r32) * 144 + (16 * kk + 8 * hi) * 2);
#pragma unroll
                for (int kk = 0; kk < 4; ++kk)
#pragma unroll
                    for (int kb = 0; kb < 2; ++kb) st[kb] = MFMA32(kf[kb][kk], qf[kk], kk == 0 ? negm : st[kb]);
            }
            bf16x8 vf[3][DV / 32];
#define AT_VLOAD(g, dst) do { _Pragma("unroll") for (int d = 0; d < DV / 32; ++d) { dst[d] = *(const LAS bf16x8*)(Vb + (32 * d + r32) * 144 + (g) * 32 + hi * 16); } } while (0)
            AT_VLOAD(0, vf[0]); AT_VLOAD(1, vf[1]);
            if (MODE == 1 && lat) {
                const LAS float* rpbL = (const LAS float*)(lds + AT_RPB);
                const int kr = tok0 >> 6, cs = min(max(qc - 8, 0), 48), rb = (kr - qr + 7) * 32 - qc + 15 + 4 * hi;
#pragma unroll
                for (int kb = 0; kb < 2; ++kb)
#pragma unroll
                    for (int i = 0; i < 16; ++i) { const int kcc = 32 * kb + (i & 3) + 8 * (i >> 2); const bool valid = (unsigned)(kcc + 4 * hi - cs) < 16u;
                        const float bias = rpbL[valid ? rb + kcc : 0]; st[kb][i] = valid ? st[kb][i] + bias : NEGBIG; }
            }
            if (MODE == 2 && lat) {
#pragma unroll
                for (int kb = 0; kb < 2; ++kb)
#pragma unroll
                    for (int i = 0; i < 16; ++i) { const int kpos = tok0 + 32 * kb + (i & 3) + 8 * (i >> 2) + 4 * hi; const bool valid = (unsigned)(kpos - qtok + 128) <= 256u;
                        st[kb][i] = valid ? st[kb][i] : NEGBIG; }
            }
            float mxp[4];
#pragma unroll
            for (int c = 0; c < 4; ++c) { mxp[c] = fmaxf(st[0][4 * c], st[1][4 * c]);
#pragma unroll
                for (int i = 1; i < 4; ++i) mxp[c] = fmaxf(fmaxf(mxp[c], st[0][4 * c + i]), st[1][4 * c + i]); }
            float mx = fmaxf(fmaxf(mxp[0], mxp[1]), fmaxf(mxp[2], mxp[3]));
            mx = xhalf_max(mx);
            m_run = fmaxf(m_run, mx);
            if (__builtin_amdgcn_ballot_w64(m_run > 8.f || m_run < -24.f) != 0ull) {
                const float delta = (m_run > -1e29f) ? m_run : 0.f, alpha = fast_exp2(-delta);
                m_ref += delta; m_run -= delta; l *= alpha;
#pragma unroll
                for (int d = 0; d < DV / 32; ++d) o[d] = o[d] * alpha;
#pragma unroll
                for (int kb = 0; kb < 2; ++kb)
#pragma unroll
                    for (int i = 0; i < 16; ++i) st[kb][i] -= delta;
#pragma unroll
                for (int i = 0; i < 16; ++i) negm[i] = -m_ref;
                asm volatile("" : "+v"(negm));
            }
            float rs4[4] = {0.f, 0.f, 0.f, 0.f};
#pragma unroll
            for (int kb = 0; kb < 2; ++kb)
#pragma unroll
                for (int i = 0; i < 16; ++i) { const float p = fast_exp2(st[kb][i]); st[kb][i] = p; rs4[i & 3] += p; }
            l += (rs4[0] + rs4[1]) + (rs4[2] + rs4[3]);
            {
#pragma unroll
                for (int g = 0; g < 4; ++g) {
                    if (g + 2 < 4) AT_VLOAD(g + 2, vf[(g + 2) % 3]);
                    const int kb = g >> 1, s = g & 1;
                    u32x4 pp;
                    pp.x = pk_bf16(st[kb][8 * s + 0], st[kb][8 * s + 1]); pp.y = pk_bf16(st[kb][8 * s + 2], st[kb][8 * s + 3]);
                    pp.z = pk_bf16(st[kb][8 * s + 4], st[kb][8 * s + 5]); pp.w = pk_bf16(st[kb][8 * s + 6], st[kb][8 * s + 7]);
                    const bf16x8 pf = __builtin_bit_cast(bf16x8, pp);
#pragma unroll
                    for (int d = 0; d < DV / 32; ++d) o[d] = MFMA32(vf[g % 3][d], pf, o[d]);
                }
#undef AT_VLOAD
            }
        }
        if (j + 1 < ntiles) AT_STORE(b ^ 1);
        __syncthreads();
    }
#undef AT_TOK
#undef AT_LOAD
#undef AT_STORE
    m_out = m_ref; l_out = l + __shfl_xor(l, 32);
}

template <int NB>
DI void store_rows(bf16_t* dst  , const f32x16 (&o)[NB], float sc, const float* gain, int hi) {
#pragma unroll
    for (int d = 0; d < NB; ++d)
#pragma unroll
        for (int g = 0; g < 4; ++g) {
            const int c = 32 * d + 8 * g + 4 * hi;
            f32x4 gg = {1.f, 1.f, 1.f, 1.f}; if (gain) gg = *G1((const f32x4*)(gain + c));
            u32x2 w; w.x = pk_bf16(o[d][4 * g] * sc * gg[0], o[d][4 * g + 1] * sc * gg[1]); w.y = pk_bf16(o[d][4 * g + 2] * sc * gg[2], o[d][4 * g + 3] * sc * gg[3]);
            *G1((u32x2*)(dst + c)) = w;
            if (g == 3) asm volatile("" ::: "memory");
        }
}

#define AT_DEQ_ISSUE() unsigned nxt_ = 0u; if (threadIdx.x == 0) nxt_ = __hip_atomic_fetch_add(qctr, 1u, __ATOMIC_RELAXED, __HIP_MEMORY_SCOPE_AGENT)
#define AT_DEQ_TAKE() do { volatile LAS unsigned* qw_ = (volatile LAS unsigned*)(lds + LDS_MISC + 64); if (threadIdx.x == 0) *qw_ = nxt_ + gridDim.x; __syncthreads(); \
        u = __builtin_amdgcn_readfirstlane((int)*qw_); __syncthreads(); } while (0)
DI void attn_even_phase(LAS unsigned char* lds, const float* in_subg, const float* in_rpb, unsigned char* ws, int e, unsigned* qctr) {
    const bf16_t* QK = (const bf16_t*)(ws + WS_QK); const bf16_t* Vt = (const bf16_t*)(ws + WS_VT); bf16_t* AO = (bf16_t*)(ws + WS_AO);
    float* tmp = (float*)(ws + WS_TMP) + (size_t)blockIdx.x * (64 * NTHR);
    const int tid = opaque_tid(), lane = tid & 63, wid = tid >> 6, r32 = lane & 31, hi = lane >> 5;
    const float lam = ((const float*)(ws + WS_LAM))[e];
    const float one_m = 1.f - (e == 0 ? 0.2f : 0.47071301834358416f);
    const float* sub_g = in_subg + e * 128;
    const int NU = 260 + 520;
    int u = blockIdx.x;
    while (u < NU) {
        AT_DEQ_ISSUE();
        if (u < 256 || (u >= 768 && u < 772)) {
            int qt, h;
            if (u < 256) { h = (u & 7) >> 1; qt = 2 * (u >> 3) + (u & 1); } else { qt = 64; h = u - 768; }
            const int q0 = 256 * qt, kt1 = qt < 64 ? 256 : 0, qtok = q0 + 32 * wid + r32;
            f32x16 o[4]; float m, l;
            attn_run<128, 0>(lds, QK, 2048, (2 * h) * 64, 1024 + (2 * h) * 64, Vt + (size_t)(h * 128) * TP, q0, 0, kt1, NEGBIG, 0.f, o, m, l);
            { const float inv = 1.f / l;
#pragma unroll
              for (int d = 0; d < 4; ++d)
#pragma unroll
                  for (int g = 0; g < 4; ++g) *G1((f32x4*)(tmp + tid * 64 + d * 16 + 4 * g)) = (f32x4){o[d][4 * g], o[d][4 * g + 1], o[d][4 * g + 2], o[d][4 * g + 3]} * inv; }
            attn_run<128, 0>(lds, QK, 2048, (2 * h + 1) * 64, 1024 + (2 * h + 1) * 64, Vt + (size_t)(h * 128) * TP, q0, 0, kt1, NEGBIG, 0.f, o, m, l);
            const float inv2 = lam / l; float ss = 0.f;
#pragma unroll
            for (int d = 0; d < 4; ++d) {
#pragma unroll
                for (int g = 0; g < 4; ++g) { const f32x4 t4 = *G1((const f32x4*)(tmp + tid * 64 + d * 16 + 4 * g));
#pragma unroll
                    for (int e = 0; e < 4; ++e) { const float v = t4[e] - o[d][4 * g + e] * inv2; o[d][4 * g + e] = v; ss += v * v; } }
                asm volatile("" ::: "memory");
            }
            ss += __shfl_xor(ss, 32);
            const float rstd = rsqrtf(ss * (1.f / 128.f) + NORM_EPS) * one_m;
            store_rows<4>(AO + (size_t)qtok * D + h * 128, o, rstd, sub_g, hi);
        } else {
            const int v = (u < 768) ? u - 256 : 512 + (u - 772), qt = v >> 3, head = v & 7;
            const int q0 = 256 * qt, qtok = q0 + 32 * wid + r32;
            int kt0 = 0, kt1 = 0;
            if (qt < 64) { const int r0 = 4 * qt; kt0 = min(max(r0 - 4, 0), 248); kt1 = min(max(r0 - 1, 0), 248) + 8; }
            { LAS float* rpbL = (LAS float*)(lds + AT_RPB); const float* rp = in_rpb + ((size_t)e * 8 + head) * (15 * 31);
              if (tid < 480) { const int r = tid >> 5, c = tid & 31; rpbL[tid] = (c < 31) ? G1(rp)[r * 31 + c] * LOG2E : 0.f; } }
            f32x16 o[2]; float m, l;
            attn_run<64, 1>(lds, QK, 2048, 512 + head * 64, 1536 + head * 64, Vt + (size_t)(512 + head * 64) * TP, q0, kt0, kt1, NEGBIG, 0.f, o, m, l);
            store_rows<2>(AO + (size_t)qtok * D + 512 + head * 64, o, 1.f / l, nullptr, hi);
        }
        AT_DEQ_TAKE();
    }
}
DI void attn_odd_phase(LAS unsigned char* lds, const float* in_sinks, unsigned char* ws, int od, unsigned* qctr) {
    const bf16_t* QK = (const bf16_t*)(ws + WS_QK); const bf16_t* Vt = (const bf16_t*)(ws + WS_VT); bf16_t* AO = (bf16_t*)(ws + WS_AO);
    const int tid = opaque_tid(), lane = tid & 63, wid = tid >> 6, r32 = lane & 31, hi = lane >> 5;
    const int NU = 65 * 16;
    int u = blockIdx.x;
    while (u < NU) {
        AT_DEQ_ISSUE();
        int qt = u >> 4, head = u & 15;
        if (u < 256 && gridDim.x == 256) {
            const int xcd = u & 7, i = u >> 3; head = 4 * (xcd & 3) + (i & 3); qt = 2 * (i >> 2) + (xcd >> 2); }
        const int kvh = head >> 2;
        const int q0 = 256 * qt, qtok = q0 + 32 * wid + r32;
        int kt0 = 0, kt1 = 0;
        if (qt < 64) { kt0 = max(4 * qt - 2, 0); kt1 = min(4 * qt + 6, 256); }
        const float sink = G1(in_sinks)[od * 16 + head] * LOG2E;
        f32x16 o[2]; float m, l;
        attn_run<64, 2>(lds, QK, 1280, head * 64, 1024 + kvh * 64, Vt + (size_t)(kvh * 64) * TP, q0, kt0, kt1, sink, 1.f, o, m, l);
        store_rows<2>(AO + (size_t)qtok * D + head * 64, o, 1.f / l, nullptr, hi);
        AT_DEQ_TAKE();
    }
}

DI void xpose_item(const float* W, int K, int N, bf16_t* WT, int mode, LAS float* scr, int item, int lane) {
    const int nblk = N / 32, kb = item / nblk, nb = item % nblk, k0 = 64 * kb, n0 = 32 * nb;
    float wv[32];
#pragma unroll
    for (int i = 0; i < 32; ++i) wv[i] = G1(W)[(size_t)(k0 + 2 * i + (lane >> 5)) * N + n0 + (lane & 31)];
#pragma unroll
    for (int i = 0; i < 32; ++i) scr[(2 * i + (lane >> 5)) * 33 + (lane & 31)] = wv[i];
    asm volatile("s_waitcnt lgkmcnt(0)" ::: "memory");
    const int c = lane & 7;
#pragma unroll
    for (int j = 0; j < 4; ++j) {
        const int nl = (lane >> 3) + 8 * j, n = n0 + nl; const LAS float* s = scr + (8 * c) * 33 + nl;
        int nd = n;
        if (mode == 1) { const int seg = n >> 9; nd = ((seg == 3) ? 4 : (seg == 4) ? 3 : seg) * 512 + (n & 511); }
        else if (mode == 2) nd = (n >> 4) * 32 + (n & 15);
        else if (mode == 3) nd = (n >> 4) * 32 + 16 + (n & 15);
        u32x4 o; o.x = pk_bf16(s[0 * 33], s[1 * 33]); o.y = pk_bf16(s[2 * 33], s[3 * 33]); o.z = pk_bf16(s[4 * 33], s[5 * 33]); o.w = pk_bf16(s[6 * 33], s[7 * 33]);
        *G1((u32x4*)(WT + (size_t)nd * K + k0 + 8 * c)) = o;
    }
    asm volatile("s_waitcnt lgkmcnt(0)" ::: "memory");
}

DI void prologue(LAS unsigned char* lds, const Args& a) {
    unsigned char* ws = a.ws;
    const int tid = opaque_tid(), lane = tid & 63, wave = tid >> 6, G = gridDim.x, gw = blockIdx.x * NWAVES + wave, NGW = G * NWAVES;
    float* mod = (float*)(ws + WS_MOD);
    __syncthreads();
    for (int bi = blockIdx.x; bi < 96; bi += G) {
        const int l = bi / 24, ch = bi % 24;
        LAS float* sv = (LAS float*)lds; LAS float* red = (LAS float*)(lds + 8192);
        for (int i = tid; i < 2048; i += NTHR) { const float v = (i < 1024) ? a.in[1][i] : a.in[3][i - 1024]; sv[i] = v / (1.f + expf(-v)); }
        __syncthreads();
        const float* W = a.in[4] + (size_t)l * 1024 * 6144 + ch * 256 + lane * 4;
        f32x4 ax = {0.f, 0.f, 0.f, 0.f}, ac = {0.f, 0.f, 0.f, 0.f};
        const int k0 = wave * 128;
#pragma unroll 8
        for (int k = 0; k < 128; ++k) { const f32x4 w = *G1((const f32x4*)(W + (size_t)(k0 + k) * 6144)); ax += w * sv[k0 + k]; ac += w * sv[1024 + k0 + k]; }
        *(LAS f32x4*)(red + (wave * 2 + 0) * 256 + lane * 4) = ax;
        *(LAS f32x4*)(red + (wave * 2 + 1) * 256 + lane * 4) = ac;
        __syncthreads();
        { const int g = tid >> 8, col = tid & 255; float s = a.in[5][l * 6144 + ch * 256 + col];
          for (int w = 0; w < 8; ++w) s += red[(w * 2 + g) * 256 + col];
          mod[(l * 2 + g) * 6144 + ch * 256 + col] = s; }
        __syncthreads();
    }
    for (int i = blockIdx.x * NTHR + tid; i < 4096; i += G * NTHR) {
        const int pos = i >> 4, fi = i & 15; const float inv = powf(10000.f, -(float)fi / 16.f), ang = (float)pos * inv;
        ((f32v2*)(ws + WS_ROPE))[i] = (f32v2){cosf(ang), sinf(ang)};
    }
    if (blockIdx.x == 0 && tid < 2) {
        const float* L = a.in[9] + tid * 256; float s1 = 0.f, s2 = 0.f;
        for (int i = 0; i < 64; ++i) { s1 += L[i] * L[64 + i]; s2 += L[128 + i] * L[192 + i]; }
        ((float*)(ws + WS_LAM))[tid] = expf(s1) - expf(s2) + (tid == 0 ? 0.2f : 0.47071301834358416f);
    }
    LAS float* scr = (LAS float*)(lds + wave * 8448);
    bf16_t* WinAB = (bf16_t*)(ws + WS_WINAB); bf16_t* WoutAB = (bf16_t*)(ws + WS_WOUTAB); bf16_t* WinC = (bf16_t*)(ws + WS_WINC); bf16_t* WoutC = (bf16_t*)(ws + WS_WOUTC);
    bf16_t* W13 = (bf16_t*)(ws + WS_W13); bf16_t* W2 = (bf16_t*)(ws + WS_W2);
    constexpr int NTOT = 3072 + 1024 + 1536 + 1024 + 5632 + 5632 + 5632;
    for (int it = gw; it < NTOT; it += NGW) {
        int r = it;
        if (r < 3072) { const int e = r / 1536; xpose_item(a.in[7] + (size_t)e * 1024 * 3072, 1024, 3072, WinAB + (size_t)e * 3072 * 1024, 1, scr, r % 1536, lane); continue; } r -= 3072;
        if (r < 1024) { const int e = r / 512; xpose_item(a.in[8] + (size_t)e * 1024 * 1024, 1024, 1024, WoutAB + (size_t)e * 1024 * 1024, 0, scr, r % 512, lane); continue; } r -= 1024;
        if (r < 1536) { const int e = r / 768; xpose_item(a.in[12] + (size_t)e * 1024 * 1536, 1024, 1536, WinC + (size_t)e * 1536 * 1024, 0, scr, r % 768, lane); continue; } r -= 1536;
        if (r < 1024) { const int e = r / 512; xpose_item(a.in[13] + (size_t)e * 1024 * 1024, 1024, 1024, WoutC + (size_t)e * 1024 * 1024, 0, scr, r % 512, lane); continue; } r -= 1024;
        if (r < 5632) { const int l = r / 1408; xpose_item(a.in[15] + (size_t)l * 1024 * FFN, 1024, FFN, W13 + (size_t)l * FFN2 * 1024, 2, scr, r % 1408, lane); continue; } r -= 5632;
        if (r < 5632) { const int l = r / 1408; xpose_item(a.in[16] + (size_t)l * 1024 * FFN, 1024, FFN, W13 + (size_t)l * FFN2 * 1024, 3, scr, r % 1408, lane); continue; } r -= 5632;
        { const int l = r / 1408; xpose_item(a.in[17] + (size_t)l * FFN * 1024, FFN, 1024, W2 + (size_t)l * 1024 * FFN, 0, scr, r % 1408, lane); }
    }
}

DI void norm_phase(unsigned char* ws, const float* src_x, const float* src_c  , const float* g, const float* modl  , int shift_i, int npart  ) {
    bf16_t* H = (bf16_t*)(ws + WS_H);
    const int tid = opaque_tid(), lane = tid & 63, wave = tid >> 6, gw = blockIdx.x * NWAVES + wave, NGW = gridDim.x * NWAVES;
    for (int r = gw; r < T; r += NGW) {
        const float* xr = (r < SEQ ? src_x + (size_t)r * D : src_c + (size_t)(r - SEQ) * D) + 4 * lane; const float* md = modl + (r >= SEQ ? 6144 : 0) + shift_i * 1024 + 4 * lane;
        f32x4 v[4]; float ss = 0.f;
#pragma unroll
        for (int j = 0; j < 4; ++j) v[j] = *G1((const f32x4*)(xr + 256 * j));
        if (r >= SEQ && npart > 0) {
            const float* pr = (const float*)(ws + WS_TMP) + (size_t)(r - SEQ) * D + 4 * lane;
            for (int s = 0; s < npart; ++s)
#pragma unroll
                for (int j = 0; j < 4; ++j) v[j] += *G1((const f32x4*)(pr + (size_t)s * (NCTX * D) + 256 * j));
#pragma unroll
            for (int j = 0; j < 4; ++j) *G1((f32x4*)((float*)(ws + WS_X) + (size_t)r * D + 4 * lane + 256 * j)) = v[j];
        }
#pragma unroll
        for (int j = 0; j < 4; ++j) ss += (v[j].x * v[j].x + v[j].y * v[j].y) + (v[j].z * v[j].z + v[j].w * v[j].w);
        const float rstd = rsqrtf(wave_sum(ss) * (1.f / D) + NORM_EPS);
#pragma unroll
        for (int j = 0; j < 4; ++j) {
            const f32x4 gg = *G1((const f32x4*)(g + 4 * lane + 256 * j)), sh = *G1((const f32x4*)(md + 256 * j)), sc = *G1((const f32x4*)(md + 1024 + 256 * j));
            const f32x4 y = (v[j] * rstd * gg) * (sc + 1.f) + sh;
            u32x2 w; w.x = pk_bf16(y[0], y[1]); w.y = pk_bf16(y[2], y[3]);
            *G1((u32x2*)(H + (size_t)r * D + 4 * lane + 256 * j)) = w;
        }
    }
}
DI void final_norm(const Args& a) {
    const float* X = (const float*)(a.ws + WS_X); const float* g = a.in[18];
    const int tid = opaque_tid(), lane = tid & 63, wave = tid >> 6, gw = blockIdx.x * NWAVES + wave, NGW = gridDim.x * NWAVES;
    for (int r = gw; r < SEQ; r += NGW) {
        const float* xr = X + (size_t)r * D + 4 * lane;
        f32x4 v[4]; float ss = 0.f;
#pragma unroll
        for (int j = 0; j < 4; ++j) { v[j] = *G1((const f32x4*)(xr + 256 * j)); ss += (v[j].x * v[j].x + v[j].y * v[j].y) + (v[j].z * v[j].z + v[j].w * v[j].w); }
        const float rstd = rsqrtf(wave_sum(ss) * (1.f / D) + NORM_EPS);
#pragma unroll
        for (int j = 0; j < 4; ++j) { const f32x4 gg = *G1((const f32x4*)(g + 4 * lane + 256 * j)); *G1((f32x4*)(a.out + (size_t)r * D + 4 * lane + 256 * j)) = v[j] * rstd * gg; }
    }
}

#define XB_TMO      128
#define XB_XCNT(j)  (256  + 64 * (j))
#define XB_XSUB(j)  (1280 + 64 * (j))
#define XB_XGEN(j)  (2304 + 64 * (j))
#define XB_TOP      3328
#define XB_TOPGEN   3392
#define XCD_BAR_WORDS 3456
#define XB_SPIN_CAP (1u << 18)

__device__ __forceinline__ unsigned xb_ld(unsigned* p)              { return __hip_atomic_load(p, __ATOMIC_RELAXED, __HIP_MEMORY_SCOPE_AGENT); }
__device__ __forceinline__ unsigned xb_add(unsigned* p, unsigned v) { return __hip_atomic_fetch_add(p, v, __ATOMIC_RELAXED, __HIP_MEMORY_SCOPE_AGENT); }
__device__ __forceinline__ unsigned xb_xcc_id() { return (unsigned)__builtin_amdgcn_s_getreg((3 << 11) | 20) & 0xFu; }
#define XB_SPIN(cond, bar) do { unsigned _sp = 0; while (cond) { __builtin_amdgcn_s_sleep(1); \
    if ((++_sp & 255u) == 0u) { if (xb_ld(&(bar)[XB_TMO])) break; if (_sp > XB_SPIN_CAP) { atomicAdd(&(bar)[XB_TMO], 1u); break; } } } } while (0)

struct XcdBarrier {
    unsigned* bar; unsigned x;
    volatile LAS unsigned* st;
};

__device__ __forceinline__ XcdBarrier xcd_barrier_post(unsigned* bar, volatile LAS unsigned* st) {
    XcdBarrier b; b.bar = bar; b.x = xb_xcc_id(); b.st = st;
    if (threadIdx.x == 0) (void)xb_add(&bar[XB_XCNT(b.x)], 1u);
    return b;
}
__device__ __forceinline__ void xcd_barrier_complete(unsigned* bar, unsigned x, unsigned& nloc, unsigned& nx) {
    const unsigned G = gridDim.x * gridDim.y * gridDim.z;
    unsigned sum, cnt, mine, sp = 0u;
    for (;;) {
        sum = 0u; cnt = 0u; mine = 0u;
#pragma unroll
        for (unsigned j = 0; j < 16; ++j) { const unsigned c = xb_ld(&bar[XB_XCNT(j)]); sum += c; cnt += (c > 0u) ? 1u : 0u; mine = (j == x) ? c : mine; }
        if (sum == G) break;
        __builtin_amdgcn_s_sleep(1);
        if ((++sp & 255u) == 0u) { if (xb_ld(&bar[XB_TMO])) break; if (sp > XB_SPIN_CAP) { atomicAdd(&bar[XB_TMO], 1u); break; } }
    }
    nloc = mine > 0u ? mine : 1u; nx = cnt > 0u ? cnt : 1u;
}

__device__ __forceinline__ void xcd_barrier(const XcdBarrier& b) {
    asm volatile("s_waitcnt vmcnt(0)" ::: "memory");
    __syncthreads();
    if (threadIdx.x == 0) {
        unsigned* bar = b.bar;
        __builtin_amdgcn_s_waitcnt(0);
        unsigned nloc = b.st[0], nx = b.st[1];
        if (nloc == 0u) { xcd_barrier_complete(bar, b.x, nloc, nx); b.st[0] = nloc; b.st[1] = nx; }
        const unsigned old = xb_add(&bar[XB_XSUB(b.x)], 1u);
        const unsigned gen = old / nloc;
        if (old + 1u == (gen + 1u) * nloc) {
            __builtin_amdgcn_fence(__ATOMIC_RELEASE, "agent");
            asm volatile("s_waitcnt vmcnt(0)" ::: "memory");
            const unsigned og = xb_add(&bar[XB_TOP], 1u);
            const unsigned tg = og / nx;
            if (og + 1u == (tg + 1u) * nx) xb_add(&bar[XB_TOPGEN], 1u);
            else XB_SPIN(xb_ld(&bar[XB_TOPGEN]) == tg, bar);
            __builtin_amdgcn_fence(__ATOMIC_ACQUIRE, "agent");
            xb_add(&bar[XB_XGEN(b.x)], 1u);
            asm volatile("s_waitcnt vmcnt(0)" ::: "memory");
        } else {
            XB_SPIN(xb_ld(&bar[XB_XGEN(b.x)]) == gen, bar);
            __builtin_amdgcn_fence(__ATOMIC_ACQUIRE, "agent");
            asm volatile("s_waitcnt vmcnt(0)" ::: "memory");
        }
    }
    __syncthreads();
}

#ifndef MK_SPLIT
#define MK_SPLIT 0
#endif
constexpr int N_PHASES = 2 + 7 * DEPTH;
#ifndef REP_ATT
#define REP_ATT 1
#endif
#ifndef REP_G2
#define REP_G2 1
#endif
#ifndef REP_G4
#define REP_G4 1
#endif
#ifndef REP_G
#define REP_G 1
#endif
#ifndef REP_NORM
#define REP_NORM 1
#endif
#ifndef REP_SYNC
#define REP_SYNC 1
#endif
#ifndef REP_PRO
#define REP_PRO 1
#endif

__global__ void __launch_bounds__(NTHR) mega_fwd(Args a) {
    extern __shared__ __attribute__((aligned(16))) unsigned char lds_raw[];
    LAS unsigned char* lds = (LAS unsigned char*)lds_raw;
    cg::grid_group grid = cg::this_grid();
    { volatile LAS unsigned* misc = (volatile LAS unsigned*)(lds + LDS_MISC); if (threadIdx.x < 16) misc[threadIdx.x] = 0u; }
    __syncthreads();
    XcdBarrier bar = xcd_barrier_post((unsigned*)(a.ws + WS_BAR), (volatile LAS unsigned*)(lds + LDS_MISC));
    const int lo = a.ph_lo, hi = a.ph_hi;
    int ph = 0;
#define PH_BEGIN if (ph >= lo && ph < hi) {
#define PH_END   if (ph + 1 < hi) { for (int rs_ = 0; rs_ < REP_SYNC; ++rs_) { if (lo < 0) grid.sync(); else xcd_barrier(bar); }     } } ++ph;
    PH_BEGIN for (int rp_ = 0; rp_ < REP_PRO; ++rp_) prologue(lds, a); PH_END

    for (int l = 0; l < DEPTH; ++l) {
        unsigned char* ws = a.ws; asm volatile("" : "+s"(ws));
        const float* in6 = a.in[6]; const float* in10 = a.in[10]; const float* in11 = a.in[11]; const float* in14 = a.in[14];
        asm volatile("" : "+s"(in6), "+s"(in10), "+s"(in11), "+s"(in14));
        const float* mod = (const float*)(ws + WS_MOD);
        bf16_t* H = (bf16_t*)(ws + WS_H); bf16_t* AO = (bf16_t*)(ws + WS_AO); bf16_t* QK = (bf16_t*)(ws + WS_QK); bf16_t* Vt = (bf16_t*)(ws + WS_VT); bf16_t* HID = (bf16_t*)(ws + WS_HID);
        float* X = (float*)(ws + WS_X);
        const int odd = l & 1, idx = l >> 1;
        const int Mr = (l == DEPTH - 1) ? SEQ : T;
        const float* modl = mod + (size_t)l * 2 * 6144;
        PH_BEGIN for (int rn_ = 0; rn_ < REP_NORM; ++rn_) norm_phase(ws, l == 0 ? a.in[0] : (const float*)X, l == 0 ? a.in[2] : (const float*)X + (size_t)SEQ * D, in6 + (l * 2 + 0) * D, modl, 0, l > 0 ? 11 : 0); PH_END
        PH_BEGIN {
            const bf16_t* W = odd ? (const bf16_t*)(ws + WS_WINC) + (size_t)idx * 1536 * 1024 : (const bf16_t*)(ws + WS_WINAB) + (size_t)idx * 3072 * 1024;
            const int N = odd ? 1536 : 3072;
            pg8::Gemm g{H, W, T, N, D, D}; pg8::StaticOrder S; S.init(T, N, gridDim.x, (int)blockIdx.x);
            EpiQKV E{QK, odd ? 1280 : 2048, Vt, 4, odd ? 5 : 8, (const f32v2*)(ws + WS_ROPE), odd ? 0x1fu : 0x33u};
            for (int rg_ = 0; rg_ < REP_G; ++rg_) pg8::gemm_phase<EpiQKV, pg8::StaticOrder, true, true>(lds, g, S, E);
        } PH_END
        PH_BEGIN
        for (int rep = 0; rep < REP_ATT; ++rep) { unsigned* qctr = (unsigned*)(ws + WS_BAR + 24576) + (l * REP_ATT + rep) * 64; if (odd) attn_odd_phase(lds, in14, ws, idx, qctr); else attn_even_phase(lds, in10, in11, ws, idx, qctr); }
        PH_END
        PH_BEGIN {
            const bf16_t* W = odd ? (const bf16_t*)(ws + WS_WOUTC) + (size_t)idx * 1024 * 1024 : (const bf16_t*)(ws + WS_WOUTAB) + (size_t)idx * 1024 * 1024;
            pg8::Gemm g{AO, W, SEQ, D, D, D}; pg8::StaticOrder S; S.init(SEQ, D, gridDim.x, (int)blockIdx.x);
            EpiResid E{X, modl + 2 * 1024, modl + 6144 + 2 * 1024, l == 0 ? a.in[0] : (const float*)X};
            pg8::gemm_phase<EpiResid, pg8::StaticOrder, true, true>(lds, g, S, E);
            if (l < DEPTH - 1) {
                pg8::Gemm gc{AO + (size_t)SEQ * D, W, NCTX, D, 256, D}; CtxSplit Sc{4, (int)blockIdx.x};
                EpiPartial Ec{(float*)(ws + WS_TMP), modl + 6144 + 2 * 1024};
                pg8::gemm_phase<EpiPartial, CtxSplit, true, true>(lds, gc, Sc, Ec);
            }
#if REP_G2 > 1
            { EpiResid Ez{X, (const float*)(ws + WS_ZERO), (const float*)(ws + WS_ZERO), (const float*)X}; pg8::gemm_phase<EpiResid, pg8::StaticOrder, true, true>(lds, g, S, Ez); }
#endif
        } PH_END
        PH_BEGIN for (int rn_ = 0; rn_ < REP_NORM; ++rn_) norm_phase(ws, (const float*)X, l == 0 ? a.in[2] : (const float*)X + (size_t)SEQ * D, in6 + (l * 2 + 1) * D, modl, 3, l < DEPTH - 1 ? 4 : 0); PH_END
        PH_BEGIN {
            pg8::Gemm g{H, (const bf16_t*)(ws + WS_W13) + (size_t)l * FFN2 * 1024, Mr, FFN2, D, D}; pg8::StaticOrder S; S.init(Mr, FFN2, gridDim.x, (int)blockIdx.x);
            EpiSwiGLU E{HID};
            for (int rg_ = 0; rg_ < REP_G; ++rg_) pg8::gemm_phase<EpiSwiGLU, pg8::StaticOrder, true, true>(lds, g, S, E);
        } PH_END
        PH_BEGIN {
            pg8::Gemm g{HID, (const bf16_t*)(ws + WS_W2) + (size_t)l * 1024 * FFN, SEQ, D, FFN, FFN}; pg8::StaticOrder S; S.init(SEQ, D, gridDim.x, (int)blockIdx.x);
            EpiResid E{X, modl + 5 * 1024, modl + 6144 + 5 * 1024, (const float*)X};
            pg8::gemm_phase<EpiResid, pg8::StaticOrder, true, true>(lds, g, S, E);
            if (l < DEPTH - 1) {
                pg8::Gemm gc{HID + (size_t)SEQ * FFN, (const bf16_t*)(ws + WS_W2) + (size_t)l * 1024 * FFN, NCTX, D, 256, FFN}; CtxSplit Sc{11, (int)blockIdx.x};
                EpiPartial Ec{(float*)(ws + WS_TMP), modl + 6144 + 5 * 1024};
                pg8::gemm_phase<EpiPartial, CtxSplit, true, true>(lds, gc, Sc, Ec);
            }
#if REP_G4 > 1
            { EpiResid Ez{X, (const float*)(ws + WS_ZERO), (const float*)(ws + WS_ZERO), (const float*)X}; pg8::gemm_phase<EpiResid, pg8::StaticOrder, true, true>(lds, g, S, Ez); }
#endif
        } PH_END
    }
    PH_BEGIN final_norm(a); PH_END
#undef PH_BEGIN
#undef PH_END
}

extern "C" void kernel_launch(void* const* d_in, const int* in_sizes, int n_in, void* d_out, int out_size, void* d_ws, size_t ws_size, hipStream_t stream) {
    static int grid = 0;
    if (grid == 0) {
        if (n_in != 19 || in_sizes[0] != SEQ * D || out_size != SEQ * D || ws_size < WS_END) { fprintf(stderr, "kernel_launch: unexpected shapes (n_in %d, x %d, out %d, ws %zu)\n", n_in, n_in > 0 ? in_sizes[0] : -1, out_size, ws_size); grid = -1; return; }
        int dev = 0, cus = 0, per_cu = 0;
        hipGetDevice(&dev); hipDeviceGetAttribute(&cus, hipDeviceAttributeMultiprocessorCount, dev);
        if (hipFuncSetAttribute((const void*)mega_fwd, hipFuncAttributeMaxDynamicSharedMemorySize, LDS_BYTES) != hipSuccess) { fprintf(stderr, "kernel_launch: hipFuncSetAttribute failed\n"); grid = -1; return; }
        if (hipOccupancyMaxActiveBlocksPerMultiprocessor(&per_cu, (const void*)mega_fwd, NTHR, LDS_BYTES) != hipSuccess || per_cu < 1) { fprintf(stderr, "kernel_launch: occupancy query says %d\n", per_cu); per_cu = 1; }
        (void)hipGetLastError();
        grid = cus * 1;
    }
    if (grid < 0) return;
    if (hipMemsetAsync((char*)d_ws + WS_BAR, 0, BAR_ZERO_BYTES, stream) != hipSuccess) { fprintf(stderr, "kernel_launch: memset of barrier words failed\n"); return; }
    Args a{};
    for (int i = 0; i < 19; ++i) a.in[i] = (const float*)d_in[i];
    a.out = (float*)d_out; a.ws = (unsigned char*)d_ws;
#if MK_SPLIT
    for (int p = 0; p < N_PHASES; ++p) { a.ph_lo = p; a.ph_hi = p + 1; hipLaunchKernelGGL(mega_fwd, dim3(grid), dim3(NTHR), LDS_BYTES, stream, a); }
#else
    a.ph_lo = 0; a.ph_hi = N_PHASES;
    void* args[] = {&a};
    hipError_t e = hipLaunchCooperativeKernel((const void*)mega_fwd, dim3(grid), dim3(NTHR), args, LDS_BYTES, stream);
    if (e != hipSuccess) fprintf(stderr, "cooperative launch failed: %s (grid %d)\n", hipGetErrorString(e), grid);
#endif
}
```

```cpp
#include <hip/hip_runtime.h>
#include <hip/hip_cooperative_groups.h>
#include <cstdio>
#include <cstdint>
namespace cg = cooperative_groups;
namespace pg8 {
#define PG8_LAS __attribute__((address_space(3)))
typedef unsigned short bf16_t;
typedef short bf16x8 __attribute__((ext_vector_type(8)));
typedef float f32x4 __attribute__((ext_vector_type(4)));
typedef unsigned u32x4 __attribute__((ext_vector_type(4)));
constexpr int BM = 256, BK = 64, HALF = 128, HTB = HALF * BK * 2  , STAGE_BYTES = 8 * HTB, NXCD = 8, WGM = 8;

__host__ __device__ __forceinline__ int lds_byte(int r, int c) { const int st = (r >> 4) * 2 + (c >> 5), rr = r & 15, cc = c & 31, ob = rr * 64 + cc * 2; return st * 1024 + (ob ^ (((ob >> 9) & 1) << 5)); }
__host__ __device__ __forceinline__ void stage_rc(int b, int& R, int& C) { const int st = b / 1024, sb = b % 1024, swz = sb ^ (((sb >> 9) & 1) << 5); R = (st >> 1) * 16 + swz / 64; C = (st & 1) * 32 + (swz % 64) / 2; }
__host__ __device__ __forceinline__ int perm32(int rho) { const int n = rho >> 4, i = rho & 15; return 8 * (i >> 2) + 4 * n + (i & 3); }

struct Unit { int pm, pn, ko; };
struct Gemm { const bf16_t* A; const bf16_t* Bt; int M, N, K, ld; };

struct StaticOrder {
    int nM, nN, nwg, G, c;
    __host__ __device__ void init(int M, int N, int G_, int c_) { nM = M / BM; nN = N / BM; nwg = nM * nN; G = G_; c = c_; }
    __host__ __device__ bool next(int i, Unit& u) const {
        const long L = (long)i * G + c; if (L >= nwg) return false;
        int wgid = (int)L; { const int q = nwg / NXCD, r = nwg % NXCD, xcd = wgid % NXCD, off = wgid / NXCD; wgid = (xcd < r ? xcd * (q + 1) : r * (q + 1) + (xcd - r) * q) + off; }
        const int nig = WGM * nN, gid = wgid / nig, fm = gid * WGM, gsz = (nM - fm) < WGM ? (nM - fm) : WGM;
        u.pm = fm + ((wgid % nig) % gsz); u.pn = (wgid % nig) / gsz; u.ko = 0; return true;
    }
    __device__ __forceinline__ void a_ready(const Unit&) const {}
    __device__ __forceinline__ void done(const Unit&) const {}
};

__device__ __forceinline__ unsigned cvt_pk_bf16(float lo, float hi) { unsigned r; asm volatile("v_cvt_pk_bf16_f32 %0, %1, %2" : "=v"(r) : "v"(lo), "v"(hi)); return r; }
typedef float f32x2 __attribute__((ext_vector_type(2)));
template <class Epi, class Sched, bool ALIGN_EPI = false, bool SP2 = false>
__device__ __forceinline__ void gemm_phase(PG8_LAS unsigned char* lds, const Gemm g, const Sched& S, const Epi& E) {
    int tid_ = threadIdx.x; asm volatile("" : "+v"(tid_));
    const int tid = tid_, wid = __builtin_amdgcn_readfirstlane(tid >> 6), lane = tid & 63, wr = wid >> 2, wc = wid & 3, fr = lane & 15, fq = lane >> 4;
    const int K = g.ld, nt = g.K / BK;
    unsigned voffA[2], voffB[2];
#pragma unroll
    for (int i = 0; i < 2; ++i) { int R, C; stage_rc(tid * 16 + i * 8192, R, C); const int Rb = Epi::PERM ? ((R & ~31) + perm32(R & 31)) : R;
        voffA[i] = (unsigned)(R * K + C) * 2u; voffB[i] = (unsigned)(Rb * K + C) * 2u; }
    const size_t kstep = (size_t)(BK * 2);
    const size_t hstep = (size_t)HALF * K * 2;
    const size_t tstep = 2 * hstep;
    const unsigned ldsw = (unsigned)wid * 1024u;
    const int aoff = lds_byte(wr * 64 + fr, fq * 8), boff = lds_byte(wc * 32 + fr, fq * 8);
#define PG8_SA(b, h) (((b) * 2 + (h)) * HTB)
#define PG8_SB(b, h) ((4 + (b) * 2 + (h)) * HTB)
#define PG8_STAGE(bufoff, gbase, voff) do { _Pragma("unroll") for (int _i = 0; _i < 2; ++_i) \
        __builtin_amdgcn_global_load_lds((const unsigned*)((const char*)(gbase) + (voff)[_i]), (PG8_LAS unsigned*)(lds + (bufoff) + ldsw + _i * 8192), 16, 0, 0); } while (0)
#define PG8_LDA(dst, b, h) do { _Pragma("unroll") for (int m = 0; m < 4; ++m) _Pragma("unroll") for (int k = 0; k < 2; ++k) dst[m][k] = *(const PG8_LAS bf16x8*)(lds + PG8_SA(b, h) + aoff + m * 2048 + k * 1024); } while (0)
#define PG8_LDB(dst, b, h) do { _Pragma("unroll") for (int n = 0; n < 2; ++n) _Pragma("unroll") for (int k = 0; k < 2; ++k) dst[n][k] = *(const PG8_LAS bf16x8*)(lds + PG8_SB(b, h) + boff + n * 2048 + k * 1024); } while (0)
#define PG8_MMA(ai, bj, At, Bt) do { __builtin_amdgcn_s_setprio(1); _Pragma("unroll") for (int m = 0; m < 4; ++m) _Pragma("unroll") for (int n = 0; n < 2; ++n) _Pragma("unroll") for (int k = 0; k < 2; ++k) \
        acc[ai][bj][m][n] = __builtin_amdgcn_mfma_f32_16x16x32_bf16(Bt[n][k], At[m][k], acc[ai][bj][m][n], 0, 0, 0); __builtin_amdgcn_s_setprio(0); } while (0)
#define PG8_WAIT_V(n) asm volatile("s_waitcnt vmcnt(" #n ")" ::: "memory")
#define PG8_WAIT_L(n) asm volatile("s_waitcnt lgkmcnt(" #n ")" ::: "memory")
#define PG8_BAR __builtin_amdgcn_s_barrier()
#define PG8_SCHED __builtin_amdgcn_sched_barrier(0)
    Unit cur, nxt; int ui = 0;
    if (!S.next(0, cur)) return;
    f32x4 acc[2][2][4][2];
#pragma unroll
    for (int a = 0; a < 2; ++a)
#pragma unroll
        for (int b = 0; b < 2; ++b)
#pragma unroll
            for (int m = 0; m < 4; ++m)
#pragma unroll
                for (int n = 0; n < 2; ++n) acc[a][b][m][n] = (f32x4){0.f, 0.f, 0.f, 0.f};
    bf16x8 At[4][2], B0[2][2], B1[2][2];
    const char* cA = (const char*)g.A + (size_t)cur.pm * tstep + (size_t)cur.ko * 2; const char* cB = (const char*)g.Bt + (size_t)cur.pn * tstep + (size_t)cur.ko * 2;
    S.a_ready(cur);
    if constexpr (SP2) {
        PG8_STAGE(PG8_SB(0, 0), cB, voffB); PG8_STAGE(PG8_SB(0, 1), cB + hstep, voffB); PG8_STAGE(PG8_SA(0, 0), cA, voffA); PG8_STAGE(PG8_SA(0, 1), cA + hstep, voffA);
        if (wr == 1) PG8_BAR;
        PG8_WAIT_V(2); PG8_BAR;
        PG8_STAGE(PG8_SB(1, 0), cB + kstep, voffB); PG8_STAGE(PG8_SA(1, 0), cA + kstep, voffA); PG8_STAGE(PG8_SB(1, 1), cB + hstep + kstep, voffB);
        PG8_WAIT_V(6); PG8_BAR;
    } else {
        PG8_STAGE(PG8_SB(0, 0), cB, voffB); PG8_STAGE(PG8_SA(0, 0), cA, voffA); PG8_STAGE(PG8_SB(0, 1), cB + hstep, voffB); PG8_STAGE(PG8_SA(0, 1), cA + hstep, voffA);
        if (wr == 1) PG8_BAR;
        PG8_WAIT_V(4); PG8_BAR;
        PG8_STAGE(PG8_SB(1, 0), cB + kstep, voffB); PG8_STAGE(PG8_SA(1, 0), cA + kstep, voffA); PG8_STAGE(PG8_SB(1, 1), cB + hstep + kstep, voffB);
        PG8_WAIT_V(6); PG8_BAR;
    }
    for (;;) {
        const bool has_next = S.next(ui + 1, nxt);
        const char* nA = has_next ? (const char*)g.A + (size_t)nxt.pm * tstep + (size_t)nxt.ko * 2 : cA; const char* nB = has_next ? (const char*)g.Bt + (size_t)nxt.pn * tstep + (size_t)nxt.ko * 2 : cB;
        for (int t = 0; t < nt; t += 2) {
            const bool last = (t == nt - 2);
            const char* a1 = cA + (size_t)(t + 1) * kstep;
            const char* a2 = last ? nA : cA + (size_t)(t + 2) * kstep; const char* b2 = last ? nB : cB + (size_t)(t + 2) * kstep;
            const char* a3 = a2 + kstep; const char* b3 = b2 + kstep;
            if (last && has_next) S.a_ready(nxt);
            if constexpr (SP2) {
            PG8_LDB(B0, 0, 0); PG8_LDB(B1, 0, 1); PG8_SCHED; PG8_LDA(At, 0, 0); PG8_STAGE(PG8_SA(1, 1), a1 + hstep, voffA);
            PG8_WAIT_V(8); PG8_WAIT_L(0); PG8_BAR; PG8_MMA(0, 0, At, B0); PG8_MMA(0, 1, At, B1); PG8_BAR; PG8_SCHED;
            PG8_LDA(At, 0, 1); PG8_STAGE(PG8_SB(0, 0), b2, voffB); PG8_STAGE(PG8_SB(0, 1), b2 + hstep, voffB); PG8_STAGE(PG8_SA(0, 0), a2, voffA);
            PG8_WAIT_V(8); PG8_WAIT_L(0); PG8_BAR; PG8_MMA(1, 0, At, B0); PG8_MMA(1, 1, At, B1); PG8_BAR; PG8_SCHED;
            PG8_LDB(B0, 1, 0); PG8_LDB(B1, 1, 1); PG8_SCHED; PG8_LDA(At, 1, 0); PG8_STAGE(PG8_SA(0, 1), a2 + hstep, voffA);
            PG8_WAIT_V(8); PG8_WAIT_L(0); PG8_BAR; PG8_MMA(0, 0, At, B0); PG8_MMA(0, 1, At, B1); PG8_BAR; PG8_SCHED;
            PG8_LDA(At, 1, 1); PG8_STAGE(PG8_SB(1, 0), b3, voffB); PG8_STAGE(PG8_SB(1, 1), b3 + hstep, voffB); PG8_STAGE(PG8_SA(1, 0), a3, voffA);
            PG8_WAIT_V(8); PG8_WAIT_L(0); PG8_BAR; PG8_MMA(1, 0, At, B0); PG8_MMA(1, 1, At, B1); PG8_BAR; PG8_SCHED;
            } else {
            PG8_LDB(B0, 0, 0); PG8_SCHED; PG8_LDA(At, 0, 0); PG8_STAGE(PG8_SA(1, 1), a1 + hstep, voffA);
            PG8_WAIT_L(8); PG8_BAR; PG8_WAIT_L(0); PG8_MMA(0, 0, At, B0); PG8_BAR; PG8_SCHED;
            PG8_LDB(B1, 0, 1); PG8_STAGE(PG8_SB(0, 0), b2, voffB);
            PG8_BAR; PG8_WAIT_L(0); PG8_MMA(0, 1, At, B1); PG8_BAR;
            PG8_LDA(At, 0, 1); PG8_STAGE(PG8_SA(0, 0), a2, voffA);
            PG8_BAR; PG8_WAIT_L(0); PG8_MMA(1, 0, At, B0); PG8_BAR; PG8_SCHED;
            PG8_STAGE(PG8_SB(0, 1), b2 + hstep, voffB);
            PG8_WAIT_V(6); PG8_BAR; PG8_MMA(1, 1, At, B1); PG8_BAR;
            PG8_LDB(B0, 1, 0); PG8_SCHED; PG8_LDA(At, 1, 0); PG8_STAGE(PG8_SA(0, 1), a2 + hstep, voffA);
            PG8_WAIT_L(8); PG8_BAR; PG8_WAIT_L(0); PG8_MMA(0, 0, At, B0); PG8_BAR; PG8_SCHED;
            PG8_LDB(B1, 1, 1); PG8_STAGE(PG8_SB(1, 0), b3, voffB);
            PG8_BAR; PG8_WAIT_L(0); PG8_MMA(0, 1, At, B1); PG8_BAR;
            PG8_LDA(At, 1, 1); PG8_STAGE(PG8_SA(1, 0), a3, voffA);
            PG8_BAR; PG8_WAIT_L(0); PG8_MMA(1, 0, At, B0); PG8_BAR; PG8_SCHED;
            PG8_STAGE(PG8_SB(1, 1), b3 + hstep, voffB);
            PG8_WAIT_V(6); PG8_BAR; PG8_MMA(1, 1, At, B1); PG8_BAR;
            }
        }
        if constexpr (ALIGN_EPI) { if (wr == 0) PG8_BAR; }
        if constexpr (!Epi::AFTER_DRAIN) { E(acc, cur, wr, wc, fr, fq); S.done(cur); }
        if (!has_next) break;
#pragma unroll
        for (int a = 0; a < 2; ++a)
#pragma unroll
            for (int b = 0; b < 2; ++b)
#pragma unroll
                for (int m = 0; m < 4; ++m)
#pragma unroll
                    for (int n = 0; n < 2; ++n) acc[a][b][m][n] = (f32x4){0.f, 0.f, 0.f, 0.f};
        cur = nxt; cA = nA; cB = nB; ++ui;
        if constexpr (ALIGN_EPI) { if (wr == 1) PG8_BAR; }
    }
    PG8_WAIT_V(0);
    if constexpr (!ALIGN_EPI) { if (wr == 0) PG8_BAR; }
    PG8_BAR;
    if constexpr (Epi::AFTER_DRAIN) { E.fused(acc, cur, wr, wc, fr, fq, lds, wid, lane); S.done(cur); }
#undef PG8_SA
#undef PG8_SB
#undef PG8_STAGE
#undef PG8_LDA
#undef PG8_LDB
#undef PG8_MMA
#undef PG8_WAIT_V
#undef PG8_WAIT_L
#undef PG8_BAR
#undef PG8_SCHED
}
}

using pg8::bf16_t; using pg8::bf16x8; using pg8::f32x4; using pg8::u32x4;
#define LAS __attribute__((address_space(3)))
#define DI __device__ __forceinline__
#define GAS __attribute__((address_space(1)))
#define G1(p) ((GAS __typeof__(*(p))*)(p))
typedef float f32x16 __attribute__((ext_vector_type(16)));
typedef unsigned u32x2 __attribute__((ext_vector_type(2)));
typedef short s16x4 __attribute__((ext_vector_type(4)));
typedef __bf16 bf16v2 __attribute__((ext_vector_type(2)));
typedef float f32v2 __attribute__((ext_vector_type(2)));
#define MFMA32(a, b, c) __builtin_amdgcn_mfma_f32_32x32x16_bf16((a), (b), (c), 0, 0, 0)

constexpr int D = 1024, SEQ = 16384, NCTX = 256, T = SEQ + NCTX, DEPTH = 4, FFN = 2816, FFN2 = 2 * FFN, TP = T;
constexpr int NWAVES = 8, NTHR = 512;
constexpr float NORM_EPS = 1e-6f, LOG2E = 1.4426950408889634f, QSCALE = 0.125f * LOG2E, NEGBIG = -1e30f;
constexpr int LDS_BYTES = 135168, LDS_MISC = 132096;

constexpr size_t MiB = 1u << 20;
constexpr size_t WS_ROPE = 0, WS_LAM = 64 * 1024, WS_MOD = 128 * 1024, WS_BAR = 512 * 1024, BAR_ZERO_BYTES = 32768, WS_ZERO = WS_BAR + 16384;
constexpr size_t WS_WINAB = 1 * MiB, WS_WOUTAB = 13 * MiB, WS_WINC = 17 * MiB, WS_WOUTC = 23 * MiB, WS_W13 = 27 * MiB, WS_W2 = 71 * MiB;
constexpr size_t WS_X = 93 * MiB, WS_H = 158 * MiB, WS_AO = 191 * MiB, WS_QK = 224 * MiB, WS_VT = 289 * MiB, WS_HID = 224 * MiB, WS_TMP = 322 * MiB, WS_END = 354 * MiB;

struct Args { const float* in[19]; float* out; unsigned char* ws; int ph_lo, ph_hi; };

DI unsigned pk_bf16(float a, float b) { f32v2 v = {a, b}; bf16v2 r = __builtin_convertvector(v, bf16v2); return __builtin_bit_cast(unsigned, r); }
#define dpp_f(v, ctrl) __builtin_bit_cast(float, __builtin_amdgcn_mov_dpp(__builtin_bit_cast(int, (v)), (ctrl), 0xF, 0xF, true))
DI int opaque_tid() { int t = threadIdx.x; asm volatile("" : "+v"(t)); return t; }
DI float xhalf_max(float v) {
    float a = v, b = v;
    asm volatile("s_nop 1\n\tv_permlane32_swap_b32 %0, %1" : "+v"(a), "+v"(b));
    return fmaxf(a, b); }
DI float fast_exp2(float x) { return __builtin_amdgcn_exp2f(x); }
DI float wave_sum(float v) {
    v += dpp_f(v, 0xB1);
    v += dpp_f(v, 0x4E);
    v += dpp_f(v, 0x124);
    v += dpp_f(v, 0x128);
    float a = v, b = v; asm volatile("s_nop 1\n\tv_permlane16_swap_b32 %0, %1" : "+v"(a), "+v"(b)); v = a + b;
    a = v; b = v; asm volatile("s_nop 1\n\tv_permlane32_swap_b32 %0, %1" : "+v"(a), "+v"(b)); return a + b; }

struct EpiQKV {
    static constexpr bool PERM = false, AFTER_DRAIN = false;
    bf16_t* QK; int ldqk; bf16_t* Vt; int nq, nrow; const f32v2* rope; unsigned rope_mask;
    DI void operator()(const f32x4 (&acc)[2][2][4][2], const pg8::Unit& u, int wr, int wc, int fr, int fq) const {
        if (u.pn < nrow) {
            const float sc = (u.pn < nq) ? QSCALE : 1.f;
            const bool do_rope = (u.pm < 64) && ((rope_mask >> u.pn) & 1u);
#pragma unroll
            for (int ai = 0; ai < 2; ++ai)
#pragma unroll
                for (int m = 0; m < 4; ++m) {
                    const int row = u.pm * 256 + ai * 128 + wr * 64 + m * 16 + fr;
                    f32x4 cc = {1.f, 1.f, 1.f, 1.f}, ss = {0.f, 0.f, 0.f, 0.f};
                    if (do_rope) {
                        const int pos = (wc & 1) ? (row & 63) : (row >> 6);
                        const f32x4* rp = (const f32x4*)(rope + pos * 16 + 4 * fq);
                        const f32x4 t0 = G1(rp)[0], t1 = G1(rp)[1];
                        cc = (f32x4){t0[0], t0[2], t1[0], t1[2]}; ss = (f32x4){t0[1], t0[3], t1[1], t1[3]};
                    }
#pragma unroll
                    for (int bj = 0; bj < 2; ++bj) {
                        const f32x4 x0 = acc[ai][bj][m][0], x1 = acc[ai][bj][m][1];
                        const f32x4 o0 = (x0 * cc - x1 * ss) * sc, o1 = (x1 * cc + x0 * ss) * sc;
                        bf16_t* p = QK + (size_t)row * ldqk + u.pn * 256 + bj * 128 + wc * 32 + 4 * fq;
                        u32x2 w0, w1; w0.x = pk_bf16(o0[0], o0[1]); w0.y = pk_bf16(o0[2], o0[3]); w1.x = pk_bf16(o1[0], o1[1]); w1.y = pk_bf16(o1[2], o1[3]);
                        *G1((u32x2*)p) = w0; *G1((u32x2*)(p + 16)) = w1;
                    }
                }
        } else {
            const int vr0 = (u.pn - nrow) * 256 + wc * 32 + 4 * fq;
#pragma unroll
            for (int ai = 0; ai < 2; ++ai)
#pragma unroll
                for (int m = 0; m < 4; ++m) {
                    const int row = u.pm * 256 + ai * 128 + wr * 64 + m * 16 + fr;
#pragma unroll
                    for (int bj = 0; bj < 2; ++bj)
#pragma unroll
                        for (int n = 0; n < 2; ++n) {
                            const f32x4 v = acc[ai][bj][m][n];
                            bf16_t* p = Vt + (size_t)(vr0 + bj * 128 + n * 16) * TP + row;
                            const unsigned a = pk_bf16(v[0], v[1]), b = pk_bf16(v[2], v[3]);
                            G1(p)[0] = (bf16_t)(a & 0xffffu); G1(p)[TP] = (bf16_t)(a >> 16); G1(p)[2 * (size_t)TP] = (bf16_t)(b & 0xffffu); G1(p)[3 * (size_t)TP] = (bf16_t)(b >> 16);
                        }
                }
        }
    }
};
struct EpiResid {
    static constexpr bool PERM = false, AFTER_DRAIN = false;
    float* X; const float* gate_x; const float* gate_c; const float* Xin;
    DI void operator()(const f32x4 (&acc)[2][2][4][2], const pg8::Unit& u, int wr, int wc, int fr, int fq) const {
        const float* gate = (u.pm < 64) ? gate_x : gate_c;
        const int col0 = u.pn * 256 + wc * 32 + 4 * fq;
#pragma unroll
        for (int ai = 0; ai < 2; ++ai)
#pragma unroll
            for (int m = 0; m < 4; ++m) {
                float* xr = X + (size_t)(u.pm * 256 + ai * 128 + wr * 64 + m * 16 + fr) * D + col0;
                const float* xi = Xin + (size_t)(u.pm * 256 + ai * 128 + wr * 64 + m * 16 + fr) * D + col0;
#pragma unroll
                for (int bj = 0; bj < 2; ++bj)
#pragma unroll
                    for (int n = 0; n < 2; ++n) { const f32x4 gv = *G1((const f32x4*)(gate + col0 + bj * 128 + n * 16)); *G1((f32x4*)(xr + bj * 128 + n * 16)) = *G1((const f32x4*)(xi + bj * 128 + n * 16)) + gv * acc[ai][bj][m][n]; }
                if (m & 1) asm volatile("" ::: "memory");
            }
    }
};
struct EpiPartial {
    static constexpr bool PERM = false, AFTER_DRAIN = false;
    float* part; const float* gate;
    DI void operator()(const f32x4 (&acc)[2][2][4][2], const pg8::Unit& u, int wr, int wc, int fr, int fq) const {
        const int col0 = u.pn * 256 + wc * 32 + 4 * fq;
        float* pb = part + (size_t)(u.ko >> 8) * (NCTX * D);
#pragma unroll
        for (int ai = 0; ai < 2; ++ai)
#pragma unroll
            for (int m = 0; m < 4; ++m) {
                float* xr = pb + (size_t)(ai * 128 + wr * 64 + m * 16 + fr) * D + col0;
#pragma unroll
                for (int bj = 0; bj < 2; ++bj)
#pragma unroll
                    for (int n = 0; n < 2; ++n) { const f32x4 gv = *G1((const f32x4*)(gate + col0 + bj * 128 + n * 16)); *G1((f32x4*)(xr + bj * 128 + n * 16)) = gv * acc[ai][bj][m][n]; }
                asm volatile("" ::: "memory");
            }
    }
};
struct CtxSplit {
    int nsplit, c;
    DI bool next(int i, pg8::Unit& u) const { if (i != 0 || c >= 4 * nsplit) return false; u.pm = 0; u.pn = c & 3; u.ko = (c >> 2) * 256; return true; }
    DI void a_ready(const pg8::Unit&) const {}
    DI void done(const pg8::Unit&) const {}
};
struct EpiSwiGLU {
    static constexpr bool PERM = false, AFTER_DRAIN = false;
    bf16_t* HID;
    DI void operator()(const f32x4 (&acc)[2][2][4][2], const pg8::Unit& u, int wr, int wc, int fr, int fq) const {
#pragma unroll
        for (int ai = 0; ai < 2; ++ai)
#pragma unroll
            for (int m = 0; m < 4; ++m) {
                bf16_t* hr = HID + (size_t)(u.pm * 256 + ai * 128 + wr * 64 + m * 16 + fr) * FFN + (u.pn * 256 + wc * 32) / 2 + 4 * fq;
#pragma unroll
                for (int bj = 0; bj < 2; ++bj) {
                    const f32x4 a = acc[ai][bj][m][0], b = acc[ai][bj][m][1]; f32x4 h;
#pragma unroll
                    for (int e = 0; e < 4; ++e) h[e] = a[e] * __builtin_amdgcn_rcpf(1.f + __expf(-a[e])) * b[e];
                    u32x2 w; w.x = pk_bf16(h[0], h[1]); w.y = pk_bf16(h[2], h[3]);
                    *G1((u32x2*)(hr + bj * 64)) = w;
                }
            }
    }
};

constexpr int AT_KB = 64 * 144, AT_VB = 128 * 144, AT_RPB = 2 * AT_KB + 2 * AT_VB;
static_assert(AT_RPB + 2048 <= LDS_BYTES, "attention LDS");

template <int DV, int MODE>
DI void attn_run(LAS unsigned char* lds, const bf16_t* QK, int ldqk, int qcol, int kcol, const bf16_t* Vt, int q0, int kt0, int kt1,
                 float minit, float linit, f32x16 (&o)[DV / 32], float& m_out, float& l_out) {
    const int tid = opaque_tid(), lane = tid & 63, wid = __builtin_amdgcn_readfirstlane(tid >> 6), r32 = lane & 31, hi = lane >> 5;
    const int qtok = q0 + 32 * wid + r32;
    bf16x8 qf[4];
#pragma unroll
    for (int kk = 0; kk < 4; ++kk) qf[kk] = *G1((const bf16x8*)(QK + (size_t)qtok * ldqk + qcol + 16 * kk + 8 * hi));
#pragma unroll
    for (int d = 0; d < DV / 32; ++d)
#pragma unroll
        for (int i = 0; i < 16; ++i) o[d][i] = 0.f;
    float m_ref = (linit != 0.f) ? minit : 0.f, m_run = (linit != 0.f) ? 0.f : NEGBIG, l = (hi == 0) ? linit : 0.f;
    f32x16 negm;
#pragma unroll
    for (int i = 0; i < 16; ++i) negm[i] = -m_ref;
    asm volatile("" : "+v"(negm));
    const int ntiles = 4 + (kt1 - kt0);
    const int srow = tid >> 3, sch = tid & 7;
    const int qr = (q0 >> 6) + (wid >> 1), qc = 32 * (wid & 1) + r32;
    u32x4 kreg, vreg[DV / 64];
#define AT_TOK(j) ((j) < 4 ? SEQ + 64 * (j) : 64 * (kt0 + (j) - 4))
#define AT_LOAD(j) do { const int tk_ = AT_TOK(j); kreg = *G1((const u32x4*)(QK + (size_t)(tk_ + srow) * ldqk + kcol + sch * 8)); \
        _Pragma("unroll") for (int v_ = 0; v_ < DV / 64; ++v_) vreg[v_] = *G1((const u32x4*)(Vt + (size_t)(srow + 64 * v_) * TP + tk_ + sch * 8)); } while (0)
#define AT_STORE(b) do { *(LAS u32x4*)(lds + (b) * AT_KB + srow * 144 + sch * 16) = kreg; \
        _Pragma("unroll") for (int v_ = 0; v_ < DV / 64; ++v_) { LAS unsigned char* p_ = lds + 2 * AT_KB + (b) * AT_VB + (srow + 64 * v_) * 144 + (sch >> 1) * 32 + (sch & 1) * 8; \
            *(LAS u32x2*)p_ = (u32x2){vreg[v_].x, vreg[v_].y}; *(LAS u32x2*)(p_ + 16) = (u32x2){vreg[v_].z, vreg[v_].w}; } } while (0)
    AT_LOAD(0);
    AT_STORE(0);
    __syncthreads();
    for (int j = 0; j < ntiles; ++j) {
        const int b = j & 1;
        if (j + 1 < ntiles) AT_LOAD(j + 1);
        const int tok0 = AT_TOK(j); const bool lat = j >= 4;
        bool active = true;
        if (MODE == 1 && lat) { const int kr = tok0 >> 6; const int rs = min(max(qr - 4, 0), 248); active = (kr >= rs) && (kr <= rs + 7); }
        if (MODE == 2 && lat) { const int wq0 = q0 + 32 * wid; active = (tok0 + 63 >= wq0 - 128) && (tok0 <= wq0 + 31 + 128); }
        if (active) {
            const LAS unsigned char* Kb = lds + b * AT_KB; const LAS unsigned char* Vb = lds + 2 * AT_KB + b * AT_VB;
            f32x16 st[2];
            {
                bf16x8 kf[2][4];
#pragma unroll
                for (int kb = 0; kb < 2; ++kb)
#pragma unroll
                    for (int kk = 0; kk < 4; ++kk) kf[kb][kk] = *(const LAS bf16x8*)(Kb + (32 * kb + r32) * 144 + (16 * kk + 8 * hi) * 2);
#pragma unroll
                for (int kk = 0; kk < 4; ++kk)
#pragma unroll
                    for (int kb = 0; kb < 2; ++kb) st[kb] = MFMA32(kf[kb][kk], qf[kk], kk == 0 ? negm : st[kb]);
            }
            bf16x8 vf[3][DV / 32];
#define AT_VLOAD(g, dst) do { _Pragma("unroll") for (int d = 0; d < DV / 32; ++d) { dst[d] = *(const LAS bf16x8*)(Vb + (32 * d + r32) * 144 + (g) * 32 + hi * 16); } } while (0)
            AT_VLOAD(0, vf[0]); AT_VLOAD(1, vf[1]);
            if (MODE == 1 && lat) {
                const LAS float* rpbL = (const LAS float*)(lds + AT_RPB);
                const int kr = tok0 >> 6, cs = min(max(qc - 8, 0), 48), rb = (kr - qr + 7) * 32 - qc + 15 + 4 * hi;
#pragma unroll
                for (int kb = 0; kb < 2; ++kb)
#pragma unroll
                    for (int i = 0; i < 16; ++i) { const int kcc = 32 * kb + (i & 3) + 8 * (i >> 2); const bool valid = (unsigned)(kcc + 4 * hi - cs) < 16u;
                        const float bias = rpbL[valid ? rb + kcc : 0]; st[kb][i] = valid ? st[kb][i] + bias : NEGBIG; }
            }
            if (MODE == 2 && lat) {
#pragma unroll
                for (int kb = 0; kb < 2; ++kb)
#pragma unroll
                    for (int i = 0; i < 16; ++i) { const int kpos = tok0 + 32 * kb + (i & 3) + 8 * (i >> 2) + 4 * hi; const bool valid = (unsigned)(kpos - qtok + 128) <= 256u;
                        st[kb][i] = valid ? st[kb][i] : NEGBIG; }
            }
            float mxp[4];
#pragma unroll
            for (int c = 0; c < 4; ++c) { mxp[c] = fmaxf(st[0][4 * c], st[1][4 * c]);
#pragma unroll
                for (int i = 1; i < 4; ++i) mxp[c] = fmaxf(fmaxf(mxp[c], st[0][4 * c + i]), st[1][4 * c + i]); }
            float mx = fmaxf(fmaxf(mxp[0], mxp[1]), fmaxf(mxp[2], mxp[3]));
            mx = xhalf_max(mx);
            m_run = fmaxf(m_run, mx);
            if (__builtin_amdgcn_ballot_w64(m_run > 8.f || m_run < -24.f) != 0ull) {
                const float delta = (m_run > -1e29f) ? m_run : 0.f, alpha = fast_exp2(-delta);
                m_ref += delta; m_run -= delta; l *= alpha;
#pragma unroll
                for (int d = 0; d < DV / 32; ++d) o[d] = o[d] * alpha;
#pragma unroll
                for (int kb = 0; kb < 2; ++kb)
#pragma unroll
                    for (int i = 0; i < 16; ++i) st[kb][i] -= delta;
#pragma unroll
                for (int i = 0; i < 16; ++i) negm[i] = -m_ref;
                asm volatile("" : "+v"(negm));
            }
            float rs4[4] = {0.f, 0.f, 0.f, 0.f};
#pragma unroll
            for (int kb = 0; kb < 2; ++kb)
#pragma unroll
                for (int i = 0; i < 16; ++i) { const float p = fast_exp2(st[kb][i]); st[kb][i] = p; rs4[i & 3] += p; }
            l += (rs4[0] + rs4[1]) + (rs4[2] + rs4[3]);
            {
#pragma unroll
                for (int g = 0; g < 4; ++g) {
                    if (g + 2 < 4) AT_VLOAD(g + 2, vf[(g + 2) % 3]);
                    const int kb = g >> 1, s = g & 1;
                    u32x4 pp;
                    pp.x = pk_bf16(st[kb][8 * s + 0], st[kb][8 * s + 1]); pp.y = pk_bf16(st[kb][8 * s + 2], st[kb][8 * s + 3]);
                    pp.z = pk_bf16(st[kb][8 * s + 4], st[kb][8 * s + 5]); pp.w = pk_bf16(st[kb][8 * s + 6], st[kb][8 * s + 7]);
                    const bf16x8 pf = __builtin_bit_cast(bf16x8, pp);
#pragma unroll
                    for (int d = 0; d < DV / 32; ++d) o[d] = MFMA32(vf[g % 3][d], pf, o[d]);
                }
#undef AT_VLOAD
            }
        }
        if (j + 1 < ntiles) AT_STORE(b ^ 1);
        __syncthreads();
    }
#undef AT_TOK
#undef AT_LOAD
#undef AT_STORE
    m_out = m_ref; l_out = l + __shfl_xor(l, 32);
}

template <int NB>
DI void store_rows(bf16_t* dst  , const f32x16 (&o)[NB], float sc, const float* gain, int hi) {
#pragma unroll
    for (int d = 0; d < NB; ++d)
#pragma unroll
        for (int g = 0; g < 4; ++g) {
            const int c = 32 * d + 8 * g + 4 * hi;
            f32x4 gg = {1.f, 1.f, 1.f, 1.f}; if (gain) gg = *G1((const f32x4*)(gain + c));
            u32x2 w; w.x = pk_bf16(o[d][4 * g] * sc * gg[0], o[d][4 * g + 1] * sc * gg[1]); w.y = pk_bf16(o[d][4 * g + 2] * sc * gg[2], o[d][4 * g + 3] * sc * gg[3]);
            *G1((u32x2*)(dst + c)) = w;
            if (g == 3) asm volatile("" ::: "memory");
        }
}

#define AT_DEQ_ISSUE() unsigned nxt_ = 0u; if (threadIdx.x == 0) nxt_ = __hip_atomic_fetch_add(qctr, 1u, __ATOMIC_RELAXED, __HIP_MEMORY_SCOPE_AGENT)
#define AT_DEQ_TAKE() do { volatile LAS unsigned* qw_ = (volatile LAS unsigned*)(lds + LDS_MISC + 64); if (threadIdx.x == 0) *qw_ = nxt_ + gridDim.x; __syncthreads(); \
        u = __builtin_amdgcn_readfirstlane((int)*qw_); __syncthreads(); } while (0)
DI void attn_even_phase(LAS unsigned char* lds, const float* in_subg, const float* in_rpb, unsigned char* ws, int e, unsigned* qctr) {
    const bf16_t* QK = (const bf16_t*)(ws + WS_QK); const bf16_t* Vt = (const bf16_t*)(ws + WS_VT); bf16_t* AO = (bf16_t*)(ws + WS_AO);
    float* tmp = (float*)(ws + WS_TMP) + (size_t)blockIdx.x * (64 * NTHR);
    const int tid = opaque_tid(), lane = tid & 63, wid = tid >> 6, r32 = lane & 31, hi = lane >> 5;
    const float lam = ((const float*)(ws + WS_LAM))[e];
    const float one_m = 1.f - (e == 0 ? 0.2f : 0.47071301834358416f);
    const float* sub_g = in_subg + e * 128;
    const int NU = 260 + 520;
    const bool xs = gridDim.x == 256;
    int u = blockIdx.x, step = 0;
    while (u < NU) {
        unsigned nxt_ = 0u;
        if ((!xs || step > 0) && threadIdx.x == 0) nxt_ = __hip_atomic_fetch_add(qctr, 1u, __ATOMIC_RELAXED, __HIP_MEMORY_SCOPE_AGENT);
        if (u < 256 || (u >= 768 && u < 772)) {
            int qt, h;
            if (u < 256) { h = (u & 7) >> 1; qt = 2 * (u >> 3) + (u & 1); } else { qt = 64; h = u - 768; }
            const int q0 = 256 * qt, kt1 = qt < 64 ? 256 : 0, qtok = q0 + 32 * wid + r32;
            f32x16 o[4]; float m, l;
            attn_run<128, 0>(lds, QK, 2048, (2 * h) * 64, 1024 + (2 * h) * 64, Vt + (size_t)(h * 128) * TP, q0, 0, kt1, NEGBIG, 0.f, o, m, l);
            { const float inv = 1.f / l;
#pragma unroll
              for (int d = 0; d < 4; ++d)
#pragma unroll
                  for (int g = 0; g < 4; ++g) *G1((f32x4*)(tmp + tid * 64 + d * 16 + 4 * g)) = (f32x4){o[d][4 * g], o[d][4 * g + 1], o[d][4 * g + 2], o[d][4 * g + 3]} * inv; }
            attn_run<128, 0>(lds, QK, 2048, (2 * h + 1) * 64, 1024 + (2 * h + 1) * 64, Vt + (size_t)(h * 128) * TP, q0, 0, kt1, NEGBIG, 0.f, o, m, l);
            const float inv2 = lam / l; float ss = 0.f;
#pragma unroll
            for (int d = 0; d < 4; ++d) {
#pragma unroll
                for (int g = 0; g < 4; ++g) { const f32x4 t4 = *G1((const f32x4*)(tmp + tid * 64 + d * 16 + 4 * g));
#pragma unroll
                    for (int e = 0; e < 4; ++e) { const float v = t4[e] - o[d][4 * g + e] * inv2; o[d][4 * g + e] = v; ss += v * v; } }
                asm volatile("" ::: "memory");
            }
            ss += __shfl_xor(ss, 32);
            const float rstd = rsqrtf(ss * (1.f / 128.f) + NORM_EPS) * one_m;
            store_rows<4>(AO + (size_t)qtok * D + h * 128, o, rstd, sub_g, hi);
        } else {
            const int v = (u < 768) ? u - 256 : 512 + (u - 772), qt = v >> 3, head = v & 7;
            const int q0 = 256 * qt, qtok = q0 + 32 * wid + r32;
            int kt0 = 0, kt1 = 0;
            if (qt < 64) { const int r0 = 4 * qt; kt0 = min(max(r0 - 4, 0), 248); kt1 = min(max(r0 - 1, 0), 248) + 8; }
            { LAS float* rpbL = (LAS float*)(lds + AT_RPB); const float* rp = in_rpb + ((size_t)e * 8 + head) * (15 * 31);
              if (tid < 480) { const int r = tid >> 5, c = tid & 31; rpbL[tid] = (c < 31) ? G1(rp)[r * 31 + c] * LOG2E : 0.f; } }
            f32x16 o[2]; float m, l;
            attn_run<64, 1>(lds, QK, 2048, 512 + head * 64, 1536 + head * 64, Vt + (size_t)(512 + head * 64) * TP, q0, kt0, kt1, NEGBIG, 0.f, o, m, l);
            store_rows<2>(AO + (size_t)qtok * D + 512 + head * 64, o, 1.f / l, nullptr, hi);
        }
        if (xs && step == 0) u = 256 + (int)(blockIdx.x >> 3) * 8 + (int)(blockIdx.x & 7);
        else {
            volatile LAS unsigned* qw_ = (volatile LAS unsigned*)(lds + LDS_MISC + 64);
            if (threadIdx.x == 0) { const int n_ = (int)nxt_;
                *qw_ = (unsigned)(xs ? (n_ < 256 ? 256 + (32 + (n_ >> 3)) * 8 + (n_ & 7) : (n_ < 264 ? 772 + (n_ - 256) : (n_ < 268 ? 768 + (n_ - 264) : NU))) : n_ + (int)gridDim.x); }
            __syncthreads(); u = __builtin_amdgcn_readfirstlane((int)*qw_); __syncthreads();
        }
        ++step;
    }
}
DI void attn_odd_phase(LAS unsigned char* lds, const float* in_sinks, unsigned char* ws, int od, unsigned* qctr) {
    const bf16_t* QK = (const bf16_t*)(ws + WS_QK); const bf16_t* Vt = (const bf16_t*)(ws + WS_VT); bf16_t* AO = (bf16_t*)(ws + WS_AO);
    const int tid = opaque_tid(), lane = tid & 63, wid = tid >> 6, r32 = lane & 31, hi = lane >> 5;
    const int NU = 65 * 16;
    int u = blockIdx.x;
    while (u < NU) {
        AT_DEQ_ISSUE();
        int qt = u >> 4, head = u & 15;
        if (u < 256 && gridDim.x == 256) {
            const int xcd = u & 7, i = u >> 3; head = 4 * (xcd & 3) + (i & 3); qt = 2 * (i >> 2) + (xcd >> 2); }
        const int kvh = head >> 2;
        const int q0 = 256 * qt, qtok = q0 + 32 * wid + r32;
        int kt0 = 0, kt1 = 0;
        if (qt < 64) { kt0 = max(4 * qt - 2, 0); kt1 = min(4 * qt + 6, 256); }
        const float sink = G1(in_sinks)[od * 16 + head] * LOG2E;
        f32x16 o[2]; float m, l;
        attn_run<64, 2>(lds, QK, 1280, head * 64, 1024 + kvh * 64, Vt + (size_t)(kvh * 64) * TP, q0, kt0, kt1, sink, 1.f, o, m, l);
        store_rows<2>(AO + (size_t)qtok * D + head * 64, o, 1.f / l, nullptr, hi);
        AT_DEQ_TAKE();
    }
}

DI void xpose_item(const float* W, int K, int N, bf16_t* WT, int mode, LAS float* scr, int item, int lane) {
    const int nblk = N / 32, kb = item / nblk, nb = item % nblk, k0 = 64 * kb, n0 = 32 * nb;
    float wv[32];
#pragma unroll
    for (int i = 0; i < 32; ++i) wv[i] = G1(W)[(size_t)(k0 + 2 * i + (lane >> 5)) * N + n0 + (lane & 31)];
#pragma unroll
    for (int i = 0; i < 32; ++i) scr[(2 * i + (lane >> 5)) * 33 + (lane & 31)] = wv[i];
    asm volatile("s_waitcnt lgkmcnt(0)" ::: "memory");
    const int c = lane & 7;
#pragma unroll
    for (int j = 0; j < 4; ++j) {
        const int nl = (lane >> 3) + 8 * j, n = n0 + nl; const LAS float* s = scr + (8 * c) * 33 + nl;
        int nd = n;
        if (mode == 1) { const int seg = n >> 9; nd = ((seg == 3) ? 4 : (seg == 4) ? 3 : seg) * 512 + (n & 511); }
        else if (mode == 2) nd = (n >> 4) * 32 + (n & 15);
        else if (mode == 3) nd = (n >> 4) * 32 + 16 + (n & 15);
        u32x4 o; o.x = pk_bf16(s[0 * 33], s[1 * 33]); o.y = pk_bf16(s[2 * 33], s[3 * 33]); o.z = pk_bf16(s[4 * 33], s[5 * 33]); o.w = pk_bf16(s[6 * 33], s[7 * 33]);
        *G1((u32x4*)(WT + (size_t)nd * K + k0 + 8 * c)) = o;
    }
    asm volatile("s_waitcnt lgkmcnt(0)" ::: "memory");
}

DI void prologue(LAS unsigned char* lds, const Args& a) {
    unsigned char* ws = a.ws;
    const int tid = opaque_tid(), lane = tid & 63, wave = tid >> 6, G = gridDim.x, gw = blockIdx.x * NWAVES + wave, NGW = G * NWAVES;
    float* mod = (float*)(ws + WS_MOD);
    __syncthreads();
    for (int bi = blockIdx.x; bi < 96; bi += G) {
        const int l = bi / 24, ch = bi % 24;
        LAS float* sv = (LAS float*)lds; LAS float* red = (LAS float*)(lds + 8192);
        for (int i = tid; i < 2048; i += NTHR) { const float v = (i < 1024) ? a.in[1][i] : a.in[3][i - 1024]; sv[i] = v / (1.f + expf(-v)); }
        __syncthreads();
        const float* W = a.in[4] + (size_t)l * 1024 * 6144 + ch * 256 + lane * 4;
        f32x4 ax = {0.f, 0.f, 0.f, 0.f}, ac = {0.f, 0.f, 0.f, 0.f};
        const int k0 = wave * 128;
#pragma unroll 8
        for (int k = 0; k < 128; ++k) { const f32x4 w = *G1((const f32x4*)(W + (size_t)(k0 + k) * 6144)); ax += w * sv[k0 + k]; ac += w * sv[1024 + k0 + k]; }
        *(LAS f32x4*)(red + (wave * 2 + 0) * 256 + lane * 4) = ax;
        *(LAS f32x4*)(red + (wave * 2 + 1) * 256 + lane * 4) = ac;
        __syncthreads();
        { const int g = tid >> 8, col = tid & 255; float s = a.in[5][l * 6144 + ch * 256 + col];
          for (int w = 0; w < 8; ++w) s += red[(w * 2 + g) * 256 + col];
          mod[(l * 2 + g) * 6144 + ch * 256 + col] = s; }
        __syncthreads();
    }
    for (int i = blockIdx.x * NTHR + tid; i < 4096; i += G * NTHR) {
        const int pos = i >> 4, fi = i & 15; const float inv = powf(10000.f, -(float)fi / 16.f), ang = (float)pos * inv;
        ((f32v2*)(ws + WS_ROPE))[i] = (f32v2){cosf(ang), sinf(ang)};
    }
    if (blockIdx.x == 0 && tid < 2) {
        const float* L = a.in[9] + tid * 256; float s1 = 0.f, s2 = 0.f;
        for (int i = 0; i < 64; ++i) { s1 += L[i] * L[64 + i]; s2 += L[128 + i] * L[192 + i]; }
        ((float*)(ws + WS_LAM))[tid] = expf(s1) - expf(s2) + (tid == 0 ? 0.2f : 0.47071301834358416f);
    }
    LAS float* scr = (LAS float*)(lds + wave * 8448);
    bf16_t* WinAB = (bf16_t*)(ws + WS_WINAB); bf16_t* WoutAB = (bf16_t*)(ws + WS_WOUTAB); bf16_t* WinC = (bf16_t*)(ws + WS_WINC); bf16_t* WoutC = (bf16_t*)(ws + WS_WOUTC);
    bf16_t* W13 = (bf16_t*)(ws + WS_W13); bf16_t* W2 = (bf16_t*)(ws + WS_W2);
    constexpr int NTOT = 3072 + 1024 + 1536 + 1024 + 5632 + 5632 + 5632;
    for (int it = gw; it < NTOT; it += NGW) {
        int r = it;
        if (r < 3072) { const int e = r / 1536; xpose_item(a.in[7] + (size_t)e * 1024 * 3072, 1024, 3072, WinAB + (size_t)e * 3072 * 1024, 1, scr, r % 1536, lane); continue; } r -= 3072;
        if (r < 1024) { const int e = r / 512; xpose_item(a.in[8] + (size_t)e * 1024 * 1024, 1024, 1024, WoutAB + (size_t)e * 1024 * 1024, 0, scr, r % 512, lane); continue; } r -= 1024;
        if (r < 1536) { const int e = r / 768; xpose_item(a.in[12] + (size_t)e * 1024 * 1536, 1024, 1536, WinC + (size_t)e * 1536 * 1024, 0, scr, r % 768, lane); continue; } r -= 1536;
        if (r < 1024) { const int e = r / 512; xpose_item(a.in[13] + (size_t)e * 1024 * 1024, 1024, 1024, WoutC + (size_t)e * 1024 * 1024, 0, scr, r % 512, lane); continue; } r -= 1024;
        if (r < 5632) { const int l = r / 1408; xpose_item(a.in[15] + (size_t)l * 1024 * FFN, 1024, FFN, W13 + (size_t)l * FFN2 * 1024, 2, scr, r % 1408, lane); continue; } r -= 5632;
        if (r < 5632) { const int l = r / 1408; xpose_item(a.in[16] + (size_t)l * 1024 * FFN, 1024, FFN, W13 + (size_t)l * FFN2 * 1024, 3, scr, r % 1408, lane); continue; } r -= 5632;
        { const int l = r / 1408; xpose_item(a.in[17] + (size_t)l * FFN * 1024, FFN, 1024, W2 + (size_t)l * 1024 * FFN, 0, scr, r % 1408, lane); }
    }
}

DI void norm_phase(unsigned char* ws, const float* src_x, const float* src_c  , const float* g, const float* modl  , int shift_i, int npart  ) {
    bf16_t* H = (bf16_t*)(ws + WS_H);
    const int tid = opaque_tid(), lane = tid & 63, wave = tid >> 6, gw = blockIdx.x * NWAVES + wave, NGW = gridDim.x * NWAVES;
    for (int r = gw; r < T; r += NGW) {
        const float* xr = (r < SEQ ? src_x + (size_t)r * D : src_c + (size_t)(r - SEQ) * D) + 4 * lane; const float* md = modl + (r >= SEQ ? 6144 : 0) + shift_i * 1024 + 4 * lane;
        f32x4 v[4]; float ss = 0.f;
#pragma unroll
        for (int j = 0; j < 4; ++j) v[j] = *G1((const f32x4*)(xr + 256 * j));
        if (r >= SEQ && npart > 0) {
            const float* pr = (const float*)(ws + WS_TMP) + (size_t)(r - SEQ) * D + 4 * lane;
            for (int s = 0; s < npart; ++s)
#pragma unroll
                for (int j = 0; j < 4; ++j) v[j] += *G1((const f32x4*)(pr + (size_t)s * (NCTX * D) + 256 * j));
#pragma unroll
            for (int j = 0; j < 4; ++j) *G1((f32x4*)((float*)(ws + WS_X) + (size_t)r * D + 4 * lane + 256 * j)) = v[j];
        }
#pragma unroll
        for (int j = 0; j < 4; ++j) ss += (v[j].x * v[j].x + v[j].y * v[j].y) + (v[j].z * v[j].z + v[j].w * v[j].w);
        const float rstd = rsqrtf(wave_sum(ss) * (1.f / D) + NORM_EPS);
#pragma unroll
        for (int j = 0; j < 4; ++j) {
            const f32x4 gg = *G1((const f32x4*)(g + 4 * lane + 256 * j)), sh = *G1((const f32x4*)(md + 256 * j)), sc = *G1((const f32x4*)(md + 1024 + 256 * j));
            const f32x4 y = (v[j] * rstd * gg) * (sc + 1.f) + sh;
            u32x2 w; w.x = pk_bf16(y[0], y[1]); w.y = pk_bf16(y[2], y[3]);
            *G1((u32x2*)(H + (size_t)r * D + 4 * lane + 256 * j)) = w;
        }
    }
}
DI void final_norm(const Args& a) {
    const float* X = (const float*)(a.ws + WS_X); const float* g = a.in[18];
    const int tid = opaque_tid(), lane = tid & 63, wave = tid >> 6, gw = blockIdx.x * NWAVES + wave, NGW = gridDim.x * NWAVES;
    for (int r = gw; r < SEQ; r += NGW) {
        const float* xr = X + (size_t)r * D + 4 * lane;
        f32x4 v[4]; float ss = 0.f;
#pragma unroll
        for (int j = 0; j < 4; ++j) { v[j] = *G1((const f32x4*)(xr + 256 * j)); ss += (v[j].x * v[j].x + v[j].y * v[j].y) + (v[j].z * v[j].z + v[j].w * v[j].w); }
        const float rstd = rsqrtf(wave_sum(ss) * (1.f / D) + NORM_EPS);
#pragma unroll
        for (int j = 0; j < 4; ++j) { const f32x4 gg = *G1((const f32x4*)(g + 4 * lane + 256 * j)); *G1((f32x4*)(a.out + (size_t)r * D + 4 * lane + 256 * j)) = v[j] * rstd * gg; }
    }
}

#define XB_TMO      128
#define XB_XCNT(j)  (256  + 64 * (j))
#define XB_XSUB(j)  (1280 + 64 * (j))
#define XB_XGEN(j)  (2304 + 64 * (j))
#define XB_TOP      3328
#define XB_TOPGEN   3392
#define XCD_BAR_WORDS 3456
#define XB_SPIN_CAP (1u << 18)

__device__ __forceinline__ unsigned xb_ld(unsigned* p)              { return __hip_atomic_load(p, __ATOMIC_RELAXED, __HIP_MEMORY_SCOPE_AGENT); }
__device__ __forceinline__ unsigned xb_add(unsigned* p, unsigned v) { return __hip_atomic_fetch_add(p, v, __ATOMIC_RELAXED, __HIP_MEMORY_SCOPE_AGENT); }
__device__ __forceinline__ unsigned xb_xcc_id() { return (unsigned)__builtin_amdgcn_s_getreg((3 << 11) | 20) & 0xFu; }
#define XB_SPIN(cond, bar) do { unsigned _sp = 0; while (cond) { __builtin_amdgcn_s_sleep(1); \
    if ((++_sp & 255u) == 0u) { if (xb_ld(&(bar)[XB_TMO])) break; if (_sp > XB_SPIN_CAP) { atomicAdd(&(bar)[XB_TMO], 1u); break; } } } } while (0)

struct XcdBarrier {
    unsigned* bar; unsigned x;
    volatile LAS unsigned* st;
};

__device__ __forceinline__ XcdBarrier xcd_barrier_post(unsigned* bar, volatile LAS unsigned* st) {
    XcdBarrier b; b.bar = bar; b.x = xb_xcc_id(); b.st = st;
    if (threadIdx.x == 0) (void)xb_add(&bar[XB_XCNT(b.x)], 1u);
    return b;
}
__device__ __forceinline__ void xcd_barrier_complete(unsigned* bar, unsigned x, unsigned& nloc, unsigned& nx) {
    const unsigned G = gridDim.x * gridDim.y * gridDim.z;
    unsigned sum, cnt, mine, sp = 0u;
    for (;;) {
        sum = 0u; cnt = 0u; mine = 0u;
#pragma unroll
        for (unsigned j = 0; j < 16; ++j) { const unsigned c = xb_ld(&bar[XB_XCNT(j)]); sum += c; cnt += (c > 0u) ? 1u : 0u; mine = (j == x) ? c : mine; }
        if (sum == G) break;
        __builtin_amdgcn_s_sleep(1);
        if ((++sp & 255u) == 0u) { if (xb_ld(&bar[XB_TMO])) break; if (sp > XB_SPIN_CAP) { atomicAdd(&bar[XB_TMO], 1u); break; } }
    }
    nloc = mine > 0u ? mine : 1u; nx = cnt > 0u ? cnt : 1u;
}

__device__ __forceinline__ void xcd_barrier(const XcdBarrier& b) {
    asm volatile("s_waitcnt vmcnt(0)" ::: "memory");
    __syncthreads();
    if (threadIdx.x == 0) {
        unsigned* bar = b.bar;
        __builtin_amdgcn_s_waitcnt(0);
        unsigned nloc = b.st[0], nx = b.st[1];
        if (nloc == 0u) { xcd_barrier_complete(bar, b.x, nloc, nx); b.st[0] = nloc; b.st[1] = nx; }
        const unsigned old = xb_add(&bar[XB_XSUB(b.x)], 1u);
        const unsigned gen = old / nloc;
        if (old + 1u == (gen + 1u) * nloc) {
            __builtin_amdgcn_fence(__ATOMIC_RELEASE, "agent");
            asm volatile("s_waitcnt vmcnt(0)" ::: "memory");
            const unsigned og = xb_add(&bar[XB_TOP], 1u);
            const unsigned tg = og / nx;
            if (og + 1u == (tg + 1u) * nx) xb_add(&bar[XB_TOPGEN], 1u);
            else XB_SPIN(xb_ld(&bar[XB_TOPGEN]) == tg, bar);
            __builtin_amdgcn_fence(__ATOMIC_ACQUIRE, "agent");
            xb_add(&bar[XB_XGEN(b.x)], 1u);
            asm volatile("s_waitcnt vmcnt(0)" ::: "memory");
        } else {
            XB_SPIN(xb_ld(&bar[XB_XGEN(b.x)]) == gen, bar);
            __builtin_amdgcn_fence(__ATOMIC_ACQUIRE, "agent");
            asm volatile("s_waitcnt vmcnt(0)" ::: "memory");
        }
    }
    __syncthreads();
}

#ifndef MK_SPLIT
#define MK_SPLIT 0
#endif
constexpr int N_PHASES = 2 + 7 * DEPTH;
#ifndef REP_ATT
#define REP_ATT 1
#endif
#ifndef REP_G2
#define REP_G2 1
#endif
#ifndef REP_G4
#define REP_G4 1
#endif
#ifndef REP_G
#define REP_G 1
#endif
#ifndef REP_NORM
#define REP_NORM 1
#endif
#ifndef REP_SYNC
#define REP_SYNC 1
#endif
#ifndef REP_PRO
#define REP_PRO 1
#endif

__global__ void __launch_bounds__(NTHR) mega_fwd(Args a) {
    extern __shared__ __attribute__((aligned(16))) unsigned char lds_raw[];
    LAS unsigned char* lds = (LAS unsigned char*)lds_raw;
    cg::grid_group grid = cg::this_grid();
    { volatile LAS unsigned* misc = (volatile LAS unsigned*)(lds + LDS_MISC); if (threadIdx.x < 16) misc[threadIdx.x] = 0u; }
    __syncthreads();
    XcdBarrier bar = xcd_barrier_post((unsigned*)(a.ws + WS_BAR), (volatile LAS unsigned*)(lds + LDS_MISC));
    const int lo = a.ph_lo, hi = a.ph_hi;
    int ph = 0;
#define PH_BEGIN if (ph >= lo && ph < hi) {
#define PH_END   if (ph + 1 < hi) { for (int rs_ = 0; rs_ < REP_SYNC; ++rs_) { if (lo < 0) grid.sync(); else xcd_barrier(bar); }     } } ++ph;
    PH_BEGIN for (int rp_ = 0; rp_ < REP_PRO; ++rp_) prologue(lds, a); PH_END

    for (int l = 0; l < DEPTH; ++l) {
        unsigned char* ws = a.ws; asm volatile("" : "+s"(ws));
        const float* in6 = a.in[6]; const float* in10 = a.in[10]; const float* in11 = a.in[11]; const float* in14 = a.in[14];
        asm volatile("" : "+s"(in6), "+s"(in10), "+s"(in11), "+s"(in14));
        const float* mod = (const float*)(ws + WS_MOD);
        bf16_t* H = (bf16_t*)(ws + WS_H); bf16_t* AO = (bf16_t*)(ws + WS_AO); bf16_t* QK = (bf16_t*)(ws + WS_QK); bf16_t* Vt = (bf16_t*)(ws + WS_VT); bf16_t* HID = (bf16_t*)(ws + WS_HID);
        float* X = (float*)(ws + WS_X);
        const int odd = l & 1, idx = l >> 1;
        const int Mr = (l == DEPTH - 1) ? SEQ : T;
        const float* modl = mod + (size_t)l * 2 * 6144;
        PH_BEGIN for (int rn_ = 0; rn_ < REP_NORM; ++rn_) norm_phase(ws, l == 0 ? a.in[0] : (const float*)X, l == 0 ? a.in[2] : (const float*)X + (size_t)SEQ * D, in6 + (l * 2 + 0) * D, modl, 0, l > 0 ? 11 : 0); PH_END
        PH_BEGIN {
            const bf16_t* W = odd ? (const bf16_t*)(ws + WS_WINC) + (size_t)idx * 1536 * 1024 : (const bf16_t*)(ws + WS_WINAB) + (size_t)idx * 3072 * 1024;
            const int N = odd ? 1536 : 3072;
            pg8::Gemm g{H, W, T, N, D, D}; pg8::StaticOrder S; S.init(T, N, gridDim.x, (int)blockIdx.x);
            EpiQKV E{QK, odd ? 1280 : 2048, Vt, 4, odd ? 5 : 8, (const f32v2*)(ws + WS_ROPE), odd ? 0x1fu : 0x33u};
            for (int rg_ = 0; rg_ < REP_G; ++rg_) pg8::gemm_phase<EpiQKV, pg8::StaticOrder, true, true>(lds, g, S, E);
        } PH_END
        PH_BEGIN
        for (int rep = 0; rep < REP_ATT; ++rep) { unsigned* qctr = (unsigned*)(ws + WS_BAR + 24576) + (l * REP_ATT + rep) * 64; if (odd) attn_odd_phase(lds, in14, ws, idx, qctr); else attn_even_phase(lds, in10, in11, ws, idx, qctr); }
        PH_END
        PH_BEGIN {
            const bf16_t* W = odd ? (const bf16_t*)(ws + WS_WOUTC) + (size_t)idx * 1024 * 1024 : (const bf16_t*)(ws + WS_WOUTAB) + (size_t)idx * 1024 * 1024;
            pg8::Gemm g{AO, W, SEQ, D, D, D}; pg8::StaticOrder S; S.init(SEQ, D, gridDim.x, (int)blockIdx.x);
            EpiResid E{X, modl + 2 * 1024, modl + 6144 + 2 * 1024, l == 0 ? a.in[0] : (const float*)X};
            pg8::gemm_phase<EpiResid, pg8::StaticOrder, true, true>(lds, g, S, E);
            if (l < DEPTH - 1) {
                pg8::Gemm gc{AO + (size_t)SEQ * D, W, NCTX, D, 256, D}; CtxSplit Sc{4, (int)blockIdx.x};
                EpiPartial Ec{(float*)(ws + WS_TMP), modl + 6144 + 2 * 1024};
                pg8::gemm_phase<EpiPartial, CtxSplit, true, true>(lds, gc, Sc, Ec);
            }
#if REP_G2 > 1
            { EpiResid Ez{X, (const float*)(ws + WS_ZERO), (const float*)(ws + WS_ZERO), (const float*)X}; pg8::gemm_phase<EpiResid, pg8::StaticOrder, true, true>(lds, g, S, Ez); }
#endif
        } PH_END
        PH_BEGIN for (int rn_ = 0; rn_ < REP_NORM; ++rn_) norm_phase(ws, (const float*)X, l == 0 ? a.in[2] : (const float*)X + (size_t)SEQ * D, in6 + (l * 2 + 1) * D, modl, 3, l < DEPTH - 1 ? 4 : 0); PH_END
        PH_BEGIN {
            pg8::Gemm g{H, (const bf16_t*)(ws + WS_W13) + (size_t)l * FFN2 * 1024, Mr, FFN2, D, D}; pg8::StaticOrder S; S.init(Mr, FFN2, gridDim.x, (int)blockIdx.x);
            EpiSwiGLU E{HID};
            for (int rg_ = 0; rg_ < REP_G; ++rg_) pg8::gemm_phase<EpiSwiGLU, pg8::StaticOrder, true, true>(lds, g, S, E);
        } PH_END
        PH_BEGIN {
            pg8::Gemm g{HID, (const bf16_t*)(ws + WS_W2) + (size_t)l * 1024 * FFN, SEQ, D, FFN, FFN}; pg8::StaticOrder S; S.init(SEQ, D, gridDim.x, (int)blockIdx.x);
            EpiResid E{X, modl + 5 * 1024, modl + 6144 + 5 * 1024, (const float*)X};
            pg8::gemm_phase<EpiResid, pg8::StaticOrder, true, true>(lds, g, S, E);
            if (l < DEPTH - 1) {
                pg8::Gemm gc{HID + (size_t)SEQ * FFN, (const bf16_t*)(ws + WS_W2) + (size_t)l * 1024 * FFN, NCTX, D, 256, FFN}; CtxSplit Sc{11, (int)blockIdx.x};
                EpiPartial Ec{(float*)(ws + WS_TMP), modl + 6144 + 5 * 1024};
                pg8::gemm_phase<EpiPartial, CtxSplit, true, true>(lds, gc, Sc, Ec);
            }
#if REP_G4 > 1
            { EpiResid Ez{X, (const float*)(ws + WS_ZERO), (const float*)(ws + WS_ZERO), (const float*)X}; pg8::gemm_phase<EpiResid, pg8::StaticOrder, true, true>(lds, g, S, Ez); }
#endif
        } PH_END
    }
    PH_BEGIN final_norm(a); PH_END
#undef PH_BEGIN
#undef PH_END
}

extern "C" void kernel_launch(void* const* d_in, const int* in_sizes, int n_in, void* d_out, int out_size, void* d_ws, size_t ws_size, hipStream_t stream) {
    static int grid = 0;
    if (grid == 0) {
        if (n_in != 19 || in_sizes[0] != SEQ * D || out_size != SEQ * D || ws_size < WS_END) { fprintf(stderr, "kernel_launch: unexpected shapes (n_in %d, x %d, out %d, ws %zu)\n", n_in, n_in > 0 ? in_sizes[0] : -1, out_size, ws_size); grid = -1; return; }
        int dev = 0, cus = 0, per_cu = 0;
        hipGetDevice(&dev); hipDeviceGetAttribute(&cus, hipDeviceAttributeMultiprocessorCount, dev);
        if (hipFuncSetAttribute((const void*)mega_fwd, hipFuncAttributeMaxDynamicSharedMemorySize, LDS_BYTES) != hipSuccess) { fprintf(stderr, "kernel_launch: hipFuncSetAttribute failed\n"); grid = -1; return; }
        if (hipOccupancyMaxActiveBlocksPerMultiprocessor(&per_cu, (const void*)mega_fwd, NTHR, LDS_BYTES) != hipSuccess || per_cu < 1) { fprintf(stderr, "kernel_launch: occupancy query says %d\n", per_cu); per_cu = 1; }
        (void)hipGetLastError();
        grid = cus * 1;
    }
    if (grid < 0) return;
    if (hipMemsetAsync((char*)d_ws + WS_BAR, 0, BAR_ZERO_BYTES, stream) != hipSuccess) { fprintf(stderr, "kernel_launch: memset of barrier words failed\n"); return; }
    Args a{};
    for (int i = 0; i < 19; ++i) a.in[i] = (const float*)d_in[i];
    a.out = (float*)d_out; a.ws = (unsigned char*)d_ws;
#if MK_SPLIT
    for (int p = 0; p < N_PHASES; ++p) { a.ph_lo = p; a.ph_hi = p + 1; hipLaunchKernelGGL(mega_fwd, dim3(grid), dim3(NTHR), LDS_BYTES, stream, a); }
#else
    a.ph_lo = 0; a.ph_hi = N_PHASES;
    void* args[] = {&a};
    hipError_t e = hipLaunchCooperativeKernel((const void*)mega_fwd, dim3(grid), dim3(NTHR), args, LDS_BYTES, stream);
    if (e != hipSuccess) fprintf(stderr, "cooperative launch failed: %s (grid %d)\n", hipGetErrorString(e), grid);
#endif
}
```

```cpp
#include <hip/hip_runtime.h>
#include <hip/hip_cooperative_groups.h>
#include <cstdio>
#include <cstdint>
namespace cg = cooperative_groups;
namespace pg8 {
#define PG8_LAS __attribute__((address_space(3)))
typedef unsigned short bf16_t;
typedef short bf16x8 __attribute__((ext_vector_type(8)));
typedef float f32x4 __attribute__((ext_vector_type(4)));
typedef unsigned u32x4 __attribute__((ext_vector_type(4)));
constexpr int BM = 256, BK = 64, HALF = 128, HTB = HALF * BK * 2  , STAGE_BYTES = 8 * HTB, NXCD = 8, WGM = 8;

__host__ __device__ __forceinline__ int lds_byte(int r, int c) { const int st = (r >> 4) * 2 + (c >> 5), rr = r & 15, cc = c & 31, ob = rr * 64 + cc * 2; return st * 1024 + (ob ^ (((ob >> 9) & 1) << 5)); }
__host__ __device__ __forceinline__ void stage_rc(int b, int& R, int& C) { const int st = b / 1024, sb = b % 1024, swz = sb ^ (((sb >> 9) & 1) << 5); R = (st >> 1) * 16 + swz / 64; C = (st & 1) * 32 + (swz % 64) / 2; }
__host__ __device__ __forceinline__ int perm32(int rho) { const int n = rho >> 4, i = rho & 15; return 8 * (i >> 2) + 4 * n + (i & 3); }

struct Unit { int pm, pn, ko; };
struct Gemm { const bf16_t* A; const bf16_t* Bt; int M, N, K, ld; };

struct StaticOrder {
    int nM, nN, nwg, G, c;
    __host__ __device__ void init(int M, int N, int G_, int c_) { nM = M / BM; nN = N / BM; nwg = nM * nN; G = G_; c = c_; }
    __host__ __device__ bool next(int i, Unit& u) const {
        const long L = (long)i * G + c; if (L >= nwg) return false;
        int wgid = (int)L; { const int q = nwg / NXCD, r = nwg % NXCD, xcd = wgid % NXCD, off = wgid / NXCD; wgid = (xcd < r ? xcd * (q + 1) : r * (q + 1) + (xcd - r) * q) + off; }
        const int nig = WGM * nN, gid = wgid / nig, fm = gid * WGM, gsz = (nM - fm) < WGM ? (nM - fm) : WGM;
        u.pm = fm + ((wgid % nig) % gsz); u.pn = (wgid % nig) / gsz; u.ko = 0; return true;
    }
    __device__ __forceinline__ void a_ready(const Unit&) const {}
    __device__ __forceinline__ void done(const Unit&) const {}
};

__device__ __forceinline__ unsigned cvt_pk_bf16(float lo, float hi) { unsigned r; asm volatile("v_cvt_pk_bf16_f32 %0, %1, %2" : "=v"(r) : "v"(lo), "v"(hi)); return r; }
typedef float f32x2 __attribute__((ext_vector_type(2)));
template <class Epi, class Sched, bool ALIGN_EPI = false, bool SP2 = false>
__device__ __forceinline__ void gemm_phase(PG8_LAS unsigned char* lds, const Gemm g, const Sched& S, const Epi& E) {
    int tid_ = threadIdx.x; asm volatile("" : "+v"(tid_));
    const int tid = tid_, wid = __builtin_amdgcn_readfirstlane(tid >> 6), lane = tid & 63, wr = wid >> 2, wc = wid & 3, fr = lane & 15, fq = lane >> 4;
    const int K = g.ld, nt = g.K / BK;
    unsigned voffA[2], voffB[2];
#pragma unroll
    for (int i = 0; i < 2; ++i) { int R, C; stage_rc(tid * 16 + i * 8192, R, C); const int Rb = Epi::PERM ? ((R & ~31) + perm32(R & 31)) : R;
        voffA[i] = (unsigned)(R * K + C) * 2u; voffB[i] = (unsigned)(Rb * K + C) * 2u; }
    const size_t kstep = (size_t)(BK * 2);
    const size_t hstep = (size_t)HALF * K * 2;
    const size_t tstep = 2 * hstep;
    const unsigned ldsw = (unsigned)wid * 1024u;
    const int aoff = lds_byte(wr * 64 + fr, fq * 8), boff = lds_byte(wc * 32 + fr, fq * 8);
#define PG8_SA(b, h) (((b) * 2 + (h)) * HTB)
#define PG8_SB(b, h) ((4 + (b) * 2 + (h)) * HTB)
#define PG8_STAGE(bufoff, gbase, voff) do { _Pragma("unroll") for (int _i = 0; _i < 2; ++_i) \
        __builtin_amdgcn_global_load_lds((const unsigned*)((const char*)(gbase) + (voff)[_i]), (PG8_LAS unsigned*)(lds + (bufoff) + ldsw + _i * 8192), 16, 0, 0); } while (0)
#define PG8_LDA(dst, b, h) do { _Pragma("unroll") for (int m = 0; m < 4; ++m) _Pragma("unroll") for (int k = 0; k < 2; ++k) dst[m][k] = *(const PG8_LAS bf16x8*)(lds + PG8_SA(b, h) + aoff + m * 2048 + k * 1024); } while (0)
#define PG8_LDB(dst, b, h) do { _Pragma("unroll") for (int n = 0; n < 2; ++n) _Pragma("unroll") for (int k = 0; k < 2; ++k) dst[n][k] = *(const PG8_LAS bf16x8*)(lds + PG8_SB(b, h) + boff + n * 2048 + k * 1024); } while (0)
#define PG8_MMA(ai, bj, At, Bt) do { __builtin_amdgcn_s_setprio(1); _Pragma("unroll") for (int m = 0; m < 4; ++m) _Pragma("unroll") for (int n = 0; n < 2; ++n) _Pragma("unroll") for (int k = 0; k < 2; ++k) \
        acc[ai][bj][m][n] = __builtin_amdgcn_mfma_f32_16x16x32_bf16(Bt[n][k], At[m][k], acc[ai][bj][m][n], 0, 0, 0); __builtin_amdgcn_s_setprio(0); } while (0)
#define PG8_WAIT_V(n) asm volatile("s_waitcnt vmcnt(" #n ")" ::: "memory")
#define PG8_WAIT_L(n) asm volatile("s_waitcnt lgkmcnt(" #n ")" ::: "memory")
#define PG8_BAR __builtin_amdgcn_s_barrier()
#define PG8_SCHED __builtin_amdgcn_sched_barrier(0)
    Unit cur, nxt; int ui = 0;
    if (!S.next(0, cur)) return;
    f32x4 acc[2][2][4][2];
#pragma unroll
    for (int a = 0; a < 2; ++a)
#pragma unroll
        for (int b = 0; b < 2; ++b)
#pragma unroll
            for (int m = 0; m < 4; ++m)
#pragma unroll
                for (int n = 0; n < 2; ++n) acc[a][b][m][n] = (f32x4){0.f, 0.f, 0.f, 0.f};
    bf16x8 At[4][2], B0[2][2], B1[2][2];
    const char* cA = (const char*)g.A + (size_t)cur.pm * tstep + (size_t)cur.ko * 2; const char* cB = (const char*)g.Bt + (size_t)cur.pn * tstep + (size_t)cur.ko * 2;
    S.a_ready(cur);
    if constexpr (SP2) {
        PG8_STAGE(PG8_SB(0, 0), cB, voffB); PG8_STAGE(PG8_SB(0, 1), cB + hstep, voffB); PG8_STAGE(PG8_SA(0, 0), cA, voffA); PG8_STAGE(PG8_SA(0, 1), cA + hstep, voffA);
        if (wr == 1) PG8_BAR;
        PG8_WAIT_V(2); PG8_BAR;
        PG8_STAGE(PG8_SB(1, 0), cB + kstep, voffB); PG8_STAGE(PG8_SA(1, 0), cA + kstep, voffA); PG8_STAGE(PG8_SB(1, 1), cB + hstep + kstep, voffB);
        PG8_WAIT_V(6); PG8_BAR;
    } else {
        PG8_STAGE(PG8_SB(0, 0), cB, voffB); PG8_STAGE(PG8_SA(0, 0), cA, voffA); PG8_STAGE(PG8_SB(0, 1), cB + hstep, voffB); PG8_STAGE(PG8_SA(0, 1), cA + hstep, voffA);
        if (wr == 1) PG8_BAR;
        PG8_WAIT_V(4); PG8_BAR;
        PG8_STAGE(PG8_SB(1, 0), cB + kstep, voffB); PG8_STAGE(PG8_SA(1, 0), cA + kstep, voffA); PG8_STAGE(PG8_SB(1, 1), cB + hstep + kstep, voffB);
        PG8_WAIT_V(6); PG8_BAR;
    }
    for (;;) {
        const bool has_next = S.next(ui + 1, nxt);
        const char* nA = has_next ? (const char*)g.A + (size_t)nxt.pm * tstep + (size_t)nxt.ko * 2 : cA; const char* nB = has_next ? (const char*)g.Bt + (size_t)nxt.pn * tstep + (size_t)nxt.ko * 2 : cB;
        for (int t = 0; t < nt; t += 2) {
            const bool last = (t == nt - 2);
            const char* a1 = cA + (size_t)(t + 1) * kstep;
            const char* a2 = last ? nA : cA + (size_t)(t + 2) * kstep; const char* b2 = last ? nB : cB + (size_t)(t + 2) * kstep;
            const char* a3 = a2 + kstep; const char* b3 = b2 + kstep;
            if (last && has_next) S.a_ready(nxt);
            if constexpr (SP2) {
            PG8_LDB(B0, 0, 0); PG8_LDB(B1, 0, 1); PG8_SCHED; PG8_LDA(At, 0, 0); PG8_STAGE(PG8_SA(1, 1), a1 + hstep, voffA);
            PG8_WAIT_V(8); PG8_WAIT_L(0); PG8_BAR; PG8_MMA(0, 0, At, B0); PG8_MMA(0, 1, At, B1); PG8_BAR; PG8_SCHED;
            PG8_LDA(At, 0, 1); PG8_STAGE(PG8_SB(0, 0), b2, voffB); PG8_STAGE(PG8_SB(0, 1), b2 + hstep, voffB); PG8_STAGE(PG8_SA(0, 0), a2, voffA);
            PG8_WAIT_V(8); PG8_WAIT_L(0); PG8_BAR; PG8_MMA(1, 0, At, B0); PG8_MMA(1, 1, At, B1); PG8_BAR; PG8_SCHED;
            PG8_LDB(B0, 1, 0); PG8_LDB(B1, 1, 1); PG8_SCHED; PG8_LDA(At, 1, 0); PG8_STAGE(PG8_SA(0, 1), a2 + hstep, voffA);
            PG8_WAIT_V(8); PG8_WAIT_L(0); PG8_BAR; PG8_MMA(0, 0, At, B0); PG8_MMA(0, 1, At, B1); PG8_BAR; PG8_SCHED;
            PG8_LDA(At, 1, 1); PG8_STAGE(PG8_SB(1, 0), b3, voffB); PG8_STAGE(PG8_SB(1, 1), b3 + hstep, voffB); PG8_STAGE(PG8_SA(1, 0), a3, voffA);
            PG8_WAIT_V(8); PG8_WAIT_L(0); PG8_BAR; PG8_MMA(1, 0, At, B0); PG8_MMA(1, 1, At, B1); PG8_BAR; PG8_SCHED;
            } else {
            PG8_LDB(B0, 0, 0); PG8_SCHED; PG8_LDA(At, 0, 0); PG8_STAGE(PG8_SA(1, 1), a1 + hstep, voffA);
            PG8_WAIT_L(8); PG8_BAR; PG8_WAIT_L(0); PG8_MMA(0, 0, At, B0); PG8_BAR; PG8_SCHED;
            PG8_LDB(B1, 0, 1); PG8_STAGE(PG8_SB(0, 0), b2, voffB);
            PG8_BAR; PG8_WAIT_L(0); PG8_MMA(0, 1, At, B1); PG8_BAR;
            PG8_LDA(At, 0, 1); PG8_STAGE(PG8_SA(0, 0), a2, voffA);
            PG8_BAR; PG8_WAIT_L(0); PG8_MMA(1, 0, At, B0); PG8_BAR; PG8_SCHED;
            PG8_STAGE(PG8_SB(0, 1), b2 + hstep, voffB);
            PG8_WAIT_V(6); PG8_BAR; PG8_MMA(1, 1, At, B1); PG8_BAR;
            PG8_LDB(B0, 1, 0); PG8_SCHED; PG8_LDA(At, 1, 0); PG8_STAGE(PG8_SA(0, 1), a2 + hstep, voffA);
            PG8_WAIT_L(8); PG8_BAR; PG8_WAIT_L(0); PG8_MMA(0, 0, At, B0); PG8_BAR; PG8_SCHED;
            PG8_LDB(B1, 1, 1); PG8_STAGE(PG8_SB(1, 0), b3, voffB);
            PG8_BAR; PG8_WAIT_L(0); PG8_MMA(0, 1, At, B1); PG8_BAR;
            PG8_LDA(At, 1, 1); PG8_STAGE(PG8_SA(1, 0), a3, voffA);
            PG8_BAR; PG8_WAIT_L(0); PG8_MMA(1, 0, At, B0); PG8_BAR; PG8_SCHED;
            PG8_STAGE(PG8_SB(1, 1), b3 + hstep, voffB);
            PG8_WAIT_V(6); PG8_BAR; PG8_MMA(1, 1, At, B1); PG8_BAR;
            }
        }
        if constexpr (ALIGN_EPI) { if (wr == 0) PG8_BAR; }
        if constexpr (!Epi::AFTER_DRAIN) { E(acc, cur, wr, wc, fr, fq); S.done(cur); }
        if (!has_next) break;
#pragma unroll
        for (int a = 0; a < 2; ++a)
#pragma unroll
            for (int b = 0; b < 2; ++b)
#pragma unroll
                for (int m = 0; m < 4; ++m)
#pragma unroll
                    for (int n = 0; n < 2; ++n) acc[a][b][m][n] = (f32x4){0.f, 0.f, 0.f, 0.f};
        cur = nxt; cA = nA; cB = nB; ++ui;
        if constexpr (ALIGN_EPI) { if (wr == 1) PG8_BAR; }
    }
    PG8_WAIT_V(0);
    if constexpr (!ALIGN_EPI) { if (wr == 0) PG8_BAR; }
    PG8_BAR;
    if constexpr (Epi::AFTER_DRAIN) { E.fused(acc, cur, wr, wc, fr, fq, lds, wid, lane); S.done(cur); }
#undef PG8_SA
#undef PG8_SB
#undef PG8_STAGE
#undef PG8_LDA
#undef PG8_LDB
#undef PG8_MMA
#undef PG8_WAIT_V
#undef PG8_WAIT_L
#undef PG8_BAR
#undef PG8_SCHED
}
}

using pg8::bf16_t; using pg8::bf16x8; using pg8::f32x4; using pg8::u32x4;
#define LAS __attribute__((address_space(3)))
#define DI __device__ __forceinline__
#define GAS __attribute__((address_space(1)))
#define G1(p) ((GAS __typeof__(*(p))*)(p))
typedef float f32x16 __attribute__((ext_vector_type(16)));
typedef unsigned u32x2 __attribute__((ext_vector_type(2)));
typedef short s16x4 __attribute__((ext_vector_type(4)));
typedef __bf16 bf16v2 __attribute__((ext_vector_type(2)));
typedef float f32v2 __attribute__((ext_vector_type(2)));
#define MFMA32(a, b, c) __builtin_amdgcn_mfma_f32_32x32x16_bf16((a), (b), (c), 0, 0, 0)

constexpr int D = 1024, SEQ = 16384, NCTX = 256, T = SEQ + NCTX, DEPTH = 4, FFN = 2816, FFN2 = 2 * FFN, TP = T;
constexpr int NWAVES = 8, NTHR = 512;
constexpr float NORM_EPS = 1e-6f, LOG2E = 1.4426950408889634f, QSCALE = 0.125f * LOG2E, NEGBIG = -1e30f;
constexpr int LDS_BYTES = 135168, LDS_MISC = 132096;

constexpr size_t MiB = 1u << 20;
constexpr size_t WS_ROPE = 0, WS_LAM = 64 * 1024, WS_MOD = 128 * 1024, WS_BAR = 512 * 1024, BAR_ZERO_BYTES = 32768, WS_ZERO = WS_BAR + 16384;
constexpr size_t WS_WINAB = 1 * MiB, WS_WOUTAB = 13 * MiB, WS_WINC = 17 * MiB, WS_WOUTC = 23 * MiB, WS_W13 = 27 * MiB, WS_W2 = 71 * MiB;
constexpr size_t WS_X = 93 * MiB, WS_H = 158 * MiB, WS_AO = 191 * MiB, WS_QK = 224 * MiB, WS_VT = 289 * MiB, WS_HID = 224 * MiB, WS_TMP = 322 * MiB, WS_END = 354 * MiB;

struct Args { const float* in[19]; float* out; unsigned char* ws; int ph_lo, ph_hi; };

DI unsigned pk_bf16(float a, float b) { f32v2 v = {a, b}; bf16v2 r = __builtin_convertvector(v, bf16v2); return __builtin_bit_cast(unsigned, r); }
#define dpp_f(v, ctrl) __builtin_bit_cast(float, __builtin_amdgcn_mov_dpp(__builtin_bit_cast(int, (v)), (ctrl), 0xF, 0xF, true))
DI int opaque_tid() { int t = threadIdx.x; asm volatile("" : "+v"(t)); return t; }
DI float xhalf_max(float v) {
    float a = v, b = v;
    asm volatile("s_nop 1\n\tv_permlane32_swap_b32 %0, %1" : "+v"(a), "+v"(b));
    return fmaxf(a, b); }
DI float fast_exp2(float x) { return __builtin_amdgcn_exp2f(x); }
DI float wave_sum(float v) {
    v += dpp_f(v, 0xB1);
    v += dpp_f(v, 0x4E);
    v += dpp_f(v, 0x124);
    v += dpp_f(v, 0x128);
    float a = v, b = v; asm volatile("s_nop 1\n\tv_permlane16_swap_b32 %0, %1" : "+v"(a), "+v"(b)); v = a + b;
    a = v; b = v; asm volatile("s_nop 1\n\tv_permlane32_swap_b32 %0, %1" : "+v"(a), "+v"(b)); return a + b; }

struct EpiQKV {
    static constexpr bool PERM = false, AFTER_DRAIN = false;
    bf16_t* QK; int ldqk; bf16_t* Vt; int nq, nrow; const f32v2* rope; unsigned rope_mask;
    DI void operator()(const f32x4 (&acc)[2][2][4][2], const pg8::Unit& u, int wr, int wc, int fr, int fq) const {
        if (u.pn < nrow) {
            const float sc = (u.pn < nq) ? QSCALE : 1.f;
            const bool do_rope = (u.pm < 64) && ((rope_mask >> u.pn) & 1u);
#pragma unroll
            for (int ai = 0; ai < 2; ++ai)
#pragma unroll
                for (int m = 0; m < 4; ++m) {
                    const int row = u.pm * 256 + ai * 128 + wr * 64 + m * 16 + fr;
                    f32x4 cc = {1.f, 1.f, 1.f, 1.f}, ss = {0.f, 0.f, 0.f, 0.f};
                    if (do_rope) {
                        const int pos = (wc & 1) ? (row & 63) : (row >> 6);
                        const f32x4* rp = (const f32x4*)(rope + pos * 16 + 4 * fq);
                        const f32x4 t0 = G1(rp)[0], t1 = G1(rp)[1];
                        cc = (f32x4){t0[0], t0[2], t1[0], t1[2]}; ss = (f32x4){t0[1], t0[3], t1[1], t1[3]};
                    }
#pragma unroll
                    for (int bj = 0; bj < 2; ++bj) {
                        const f32x4 x0 = acc[ai][bj][m][0], x1 = acc[ai][bj][m][1];
                        const f32x4 o0 = (x0 * cc - x1 * ss) * sc, o1 = (x1 * cc + x0 * ss) * sc;
                        bf16_t* p = QK + (size_t)row * ldqk + u.pn * 256 + bj * 128 + wc * 32 + 4 * fq;
                        u32x2 w0, w1; w0.x = pk_bf16(o0[0], o0[1]); w0.y = pk_bf16(o0[2], o0[3]); w1.x = pk_bf16(o1[0], o1[1]); w1.y = pk_bf16(o1[2], o1[3]);
                        *G1((u32x2*)p) = w0; *G1((u32x2*)(p + 16)) = w1;
                    }
                }
        } else {
            const int vr0 = (u.pn - nrow) * 256 + wc * 32 + 4 * fq;
#pragma unroll
            for (int ai = 0; ai < 2; ++ai)
#pragma unroll
                for (int m = 0; m < 4; ++m) {
                    const int row = u.pm * 256 + ai * 128 + wr * 64 + m * 16 + fr;
#pragma unroll
                    for (int bj = 0; bj < 2; ++bj)
#pragma unroll
                        for (int n = 0; n < 2; ++n) {
                            const f32x4 v = acc[ai][bj][m][n];
                            bf16_t* p = Vt + (size_t)(vr0 + bj * 128 + n * 16) * TP + row;
                            const unsigned a = pk_bf16(v[0], v[1]), b = pk_bf16(v[2], v[3]);
                            G1(p)[0] = (bf16_t)(a & 0xffffu); G1(p)[TP] = (bf16_t)(a >> 16); G1(p)[2 * (size_t)TP] = (bf16_t)(b & 0xffffu); G1(p)[3 * (size_t)TP] = (bf16_t)(b >> 16);
                        }
                }
        }
    }
};
struct EpiResid {
    static constexpr bool PERM = false, AFTER_DRAIN = false;
    float* X; const float* gate_x; const float* gate_c; const float* Xin;
    DI void operator()(const f32x4 (&acc)[2][2][4][2], const pg8::Unit& u, int wr, int wc, int fr, int fq) const {
        const float* gate = (u.pm < 64) ? gate_x : gate_c;
        const int col0 = u.pn * 256 + wc * 32 + 4 * fq;
#pragma unroll
        for (int ai = 0; ai < 2; ++ai)
#pragma unroll
            for (int m = 0; m < 4; ++m) {
                float* xr = X + (size_t)(u.pm * 256 + ai * 128 + wr * 64 + m * 16 + fr) * D + col0;
                const float* xi = Xin + (size_t)(u.pm * 256 + ai * 128 + wr * 64 + m * 16 + fr) * D + col0;
#pragma unroll
                for (int bj = 0; bj < 2; ++bj)
#pragma unroll
                    for (int n = 0; n < 2; ++n) { const f32x4 gv = *G1((const f32x4*)(gate + col0 + bj * 128 + n * 16)); *G1((f32x4*)(xr + bj * 128 + n * 16)) = *G1((const f32x4*)(xi + bj * 128 + n * 16)) + gv * acc[ai][bj][m][n]; }
                if (m & 1) asm volatile("" ::: "memory");
            }
    }
};
struct EpiPartial {
    static constexpr bool PERM = false, AFTER_DRAIN = false;
    float* part; const float* gate;
    DI void operator()(const f32x4 (&acc)[2][2][4][2], const pg8::Unit& u, int wr, int wc, int fr, int fq) const {
        const int col0 = u.pn * 256 + wc * 32 + 4 * fq;
        float* pb = part + (size_t)(u.ko >> 8) * (NCTX * D);
#pragma unroll
        for (int ai = 0; ai < 2; ++ai)
#pragma unroll
            for (int m = 0; m < 4; ++m) {
                float* xr = pb + (size_t)(ai * 128 + wr * 64 + m * 16 + fr) * D + col0;
#pragma unroll
                for (int bj = 0; bj < 2; ++bj)
#pragma unroll
                    for (int n = 0; n < 2; ++n) { const f32x4 gv = *G1((const f32x4*)(gate + col0 + bj * 128 + n * 16)); *G1((f32x4*)(xr + bj * 128 + n * 16)) = gv * acc[ai][bj][m][n]; }
                asm volatile("" ::: "memory");
            }
    }
};
struct CtxSplit {
    int nsplit, c;
    DI bool next(int i, pg8::Unit& u) const { if (i != 0 || c >= 4 * nsplit) return false; u.pm = 0; u.pn = c & 3; u.ko = (c >> 2) * 256; return true; }
    DI void a_ready(const pg8::Unit&) const {}
    DI void done(const pg8::Unit&) const {}
};
struct EpiSwiGLU {
    static constexpr bool PERM = false, AFTER_DRAIN = false;
    bf16_t* HID;
    DI void operator()(const f32x4 (&acc)[2][2][4][2], const pg8::Unit& u, int wr, int wc, int fr, int fq) const {
#pragma unroll
        for (int ai = 0; ai < 2; ++ai)
#pragma unroll
            for (int m = 0; m < 4; ++m) {
                bf16_t* hr = HID + (size_t)(u.pm * 256 + ai * 128 + wr * 64 + m * 16 + fr) * FFN + (u.pn * 256 + wc * 32) / 2 + 4 * fq;
#pragma unroll
                for (int bj = 0; bj < 2; ++bj) {
                    const f32x4 a = acc[ai][bj][m][0], b = acc[ai][bj][m][1]; f32x4 h;
#pragma unroll
                    for (int e = 0; e < 4; ++e) h[e] = a[e] * __builtin_amdgcn_rcpf(1.f + __expf(-a[e])) * b[e];
                    u32x2 w; w.x = pk_bf16(h[0], h[1]); w.y = pk_bf16(h[2], h[3]);
                    *G1((u32x2*)(hr + bj * 64)) = w;
                }
            }
    }
};

constexpr int AT_KB = 64 * 144, AT_VB = 128 * 144, AT_RPB = 2 * AT_KB + 2 * AT_VB;
static_assert(AT_RPB + 2048 <= LDS_BYTES, "attention LDS");

template <int DV, int MODE>
DI void attn_run(LAS unsigned char* lds, const bf16_t* QK, int ldqk, int qcol, int kcol, const bf16_t* Vt, int q0, int kt0, int kt1,
                 float minit, float linit, f32x16 (&o)[DV / 32], float& m_out, float& l_out) {
    const int tid = opaque_tid(), lane = tid & 63, wid = __builtin_amdgcn_readfirstlane(tid >> 6), r32 = lane & 31, hi = lane >> 5;
    const int qtok = q0 + 32 * wid + r32;
    bf16x8 qf[4];
#pragma unroll
    for (int kk = 0; kk < 4; ++kk) qf[kk] = *G1((const bf16x8*)(QK + (size_t)qtok * ldqk + qcol + 16 * kk + 8 * hi));
#pragma unroll
    for (int d = 0; d < DV / 32; ++d)
#pragma unroll
        for (int i = 0; i < 16; ++i) o[d][i] = 0.f;
    float m_ref = (linit != 0.f) ? minit : 0.f, m_run = (linit != 0.f) ? 0.f : NEGBIG, l = (hi == 0) ? linit : 0.f;
    f32x16 negm;
#pragma unroll
    for (int i = 0; i < 16; ++i) negm[i] = -m_ref;
    asm volatile("" : "+v"(negm));
    const int ntiles = 4 + (kt1 - kt0);
    const int srow = tid >> 3, sch = tid & 7;
    const int qr = (q0 >> 6) + (wid >> 1), qc = 32 * (wid & 1) + r32;
    u32x4 kreg, vreg[DV / 64];
#define AT_TOK(j) ((j) < 4 ? SEQ + 64 * (j) : 64 * (kt0 + (j) - 4))
#define AT_LOAD(j) do { const int tk_ = AT_TOK(j); kreg = *G1((const u32x4*)(QK + (size_t)(tk_ + srow) * ldqk + kcol + sch * 8)); \
        _Pragma("unroll") for (int v_ = 0; v_ < DV / 64; ++v_) vreg[v_] = *G1((const u32x4*)(Vt + (size_t)(srow + 64 * v_) * TP + tk_ + sch * 8)); } while (0)
#define AT_STORE(b) do { *(LAS u32x4*)(lds + (b) * AT_KB + srow * 144 + sch * 16) = kreg; \
        _Pragma("unroll") for (int v_ = 0; v_ < DV / 64; ++v_) { LAS unsigned char* p_ = lds + 2 * AT_KB + (b) * AT_VB + (srow + 64 * v_) * 144 + (sch >> 1) * 32 + (sch & 1) * 8; \
            *(LAS u32x2*)p_ = (u32x2){vreg[v_].x, vreg[v_].y}; *(LAS u32x2*)(p_ + 16) = (u32x2){vreg[v_].z, vreg[v_].w}; } } while (0)
    AT_LOAD(0);
    AT_STORE(0);
    __syncthreads();
    for (int j = 0; j < ntiles; ++j) {
        const int b = j & 1;
        if (j + 1 < ntiles) AT_LOAD(j + 1);
        const int tok0 = AT_TOK(j); const bool lat = j >= 4;
        bool active = true;
        if (MODE == 1 && lat) { const int kr = tok0 >> 6; const int rs = min(max(qr - 4, 0), 248); active = (kr >= rs) && (kr <= rs + 7); }
        if (MODE == 2 && lat) { const int wq0 = q0 + 32 * wid; active = (tok0 + 63 >= wq0 - 128) && (tok0 <= wq0 + 31 + 128); }
        if (active) {
            const LAS unsigned char* Kb = lds + b * AT_KB; const LAS unsigned char* Vb = lds + 2 * AT_KB + b * AT_VB;
            f32x16 st[2];
            {
                bf16x8 kf[2][4];
#pragma unroll
                for (int kb = 0; kb < 2; ++kb)
#pragma unroll
                    for (int kk = 0; kk < 4; ++kk) kf[kb][kk] = *(const LAS bf16x8*)(Kb + (32 * kb + r32) * 144 + (16 * kk + 8 * hi) * 2);
#pragma unroll
                for (int kk = 0; kk < 4; ++kk)
#pragma unroll
                    for (int kb = 0; kb < 2; ++kb) st[kb] = MFMA32(kf[kb][kk], qf[kk], kk == 0 ? negm : st[kb]);
            }
            bf16x8 vf[3][DV / 32];
#define AT_VLOAD(g, dst) do { _Pragma("unroll") for (int d = 0; d < DV / 32; ++d) { dst[d] = *(const LAS bf16x8*)(Vb + (32 * d + r32) * 144 + (g) * 32 + hi * 16); } } while (0)
            AT_VLOAD(0, vf[0]); AT_VLOAD(1, vf[1]);
            if (MODE == 1 && lat) {
                const LAS float* rpbL = (const LAS float*)(lds + AT_RPB);
                const int kr = tok0 >> 6, cs = min(max(qc - 8, 0), 48), rb = (kr - qr + 7) * 32 - qc + 15 + 4 * hi;
#pragma unroll
                for (int kb = 0; kb < 2; ++kb)
#pragma unroll
                    for (int i = 0; i < 16; ++i) { const int kcc = 32 * kb + (i & 3) + 8 * (i >> 2); const bool valid = (unsigned)(kcc + 4 * hi - cs) < 16u;
                        const float bias = rpbL[valid ? rb + kcc : 0]; st[kb][i] = valid ? st[kb][i] + bias : NEGBIG; }
            }
            if (MODE == 2 && lat) {
#pragma unroll
                for (int kb = 0; kb < 2; ++kb)
#pragma unroll
                    for (int i = 0; i < 16; ++i) { const int kpos = tok0 + 32 * kb + (i & 3) + 8 * (i >> 2) + 4 * hi; const bool valid = (unsigned)(kpos - qtok + 128) <= 256u;
                        st[kb][i] = valid ? st[kb][i] : NEGBIG; }
            }
            float mxp[4];
#pragma unroll
            for (int c = 0; c < 4; ++c) { mxp[c] = fmaxf(st[0][4 * c], st[1][4 * c]);
#pragma unroll
                for (int i = 1; i < 4; ++i) mxp[c] = fmaxf(fmaxf(mxp[c], st[0][4 * c + i]), st[1][4 * c + i]); }
            float mx = fmaxf(fmaxf(mxp[0], mxp[1]), fmaxf(mxp[2], mxp[3]));
            mx = xhalf_max(mx);
            m_run = fmaxf(m_run, mx);
            if (__builtin_amdgcn_ballot_w64(m_run > 8.f || m_run < -24.f) != 0ull) {
                const float delta = (m_run > -1e29f) ? m_run : 0.f, alpha = fast_exp2(-delta);
                m_ref += delta; m_run -= delta; l *= alpha;
#pragma unroll
                for (int d = 0; d < DV / 32; ++d) o[d] = o[d] * alpha;
#pragma unroll
                for (int kb = 0; kb < 2; ++kb)
#pragma unroll
                    for (int i = 0; i < 16; ++i) st[kb][i] -= delta;
#pragma unroll
                for (int i = 0; i < 16; ++i) negm[i] = -m_ref;
                asm volatile("" : "+v"(negm));
            }
            float rs4[4] = {0.f, 0.f, 0.f, 0.f};
#pragma unroll
            for (int kb = 0; kb < 2; ++kb)
#pragma unroll
                for (int i = 0; i < 16; ++i) { const float p = fast_exp2(st[kb][i]); st[kb][i] = p; rs4[i & 3] += p; }
            l += (rs4[0] + rs4[1]) + (rs4[2] + rs4[3]);
            {
#pragma unroll
                for (int g = 0; g < 4; ++g) {
                    if (g + 2 < 4) AT_VLOAD(g + 2, vf[(g + 2) % 3]);
                    const int kb = g >> 1, s = g & 1;
                    u32x4 pp;
                    pp.x = pk_bf16(st[kb][8 * s + 0], st[kb][8 * s + 1]); pp.y = pk_bf16(st[kb][8 * s + 2], st[kb][8 * s + 3]);
                    pp.z = pk_bf16(st[kb][8 * s + 4], st[kb][8 * s + 5]); pp.w = pk_bf16(st[kb][8 * s + 6], st[kb][8 * s + 7]);
                    const bf16x8 pf = __builtin_bit_cast(bf16x8, pp);
#pragma unroll
                    for (int d = 0; d < DV / 32; ++d) o[d] = MFMA32(vf[g % 3][d], pf, o[d]);
                }
#undef AT_VLOAD
            }
        }
        if (j + 1 < ntiles) AT_STORE(b ^ 1);
        __syncthreads();
    }
#undef AT_TOK
#undef AT_LOAD
#undef AT_STORE
    m_out = m_ref; l_out = l + __shfl_xor(l, 32);
}

template <int NB>
DI void store_rows(bf16_t* dst  , const f32x16 (&o)[NB], float sc, const float* gain, int hi) {
#pragma unroll
    for (int d = 0; d < NB; ++d)
#pragma unroll
        for (int gp = 0; gp < 2; ++gp) {
            u32x2 w[2];
#pragma unroll
            for (int k = 0; k < 2; ++k) { const int g = 2 * gp + k, c = 32 * d + 8 * g + 4 * hi;
                f32x4 gg = {1.f, 1.f, 1.f, 1.f}; if (gain) gg = *G1((const f32x4*)(gain + c));
                w[k].x = pk_bf16(o[d][4 * g] * sc * gg[0], o[d][4 * g + 1] * sc * gg[1]); w[k].y = pk_bf16(o[d][4 * g + 2] * sc * gg[2], o[d][4 * g + 3] * sc * gg[3]); }
            unsigned ax = w[0].x, ay = w[0].y, bx = w[1].x, by = w[1].y;
            asm volatile("s_nop 1\n\tv_permlane32_swap_b32 %0, %1" : "+v"(ax), "+v"(bx));
            asm volatile("s_nop 1\n\tv_permlane32_swap_b32 %0, %1" : "+v"(ay), "+v"(by));
            *G1((u32x4*)(dst + 32 * d + 16 * gp + 8 * hi)) = (u32x4){ax, ay, bx, by};
            if (gp == 1) asm volatile("" ::: "memory");
        }
}

#define AT_DEQ_ISSUE() unsigned nxt_ = 0u; if (threadIdx.x == 0) nxt_ = __hip_atomic_fetch_add(qctr, 1u, __ATOMIC_RELAXED, __HIP_MEMORY_SCOPE_AGENT)
#define AT_DEQ_TAKE() do { volatile LAS unsigned* qw_ = (volatile LAS unsigned*)(lds + LDS_MISC + 64); if (threadIdx.x == 0) *qw_ = nxt_ + gridDim.x; __syncthreads(); \
        u = __builtin_amdgcn_readfirstlane((int)*qw_); __syncthreads(); } while (0)
DI void attn_even_phase(LAS unsigned char* lds, const float* in_subg, const float* in_rpb, unsigned char* ws, int e, unsigned* qctr) {
    const bf16_t* QK = (const bf16_t*)(ws + WS_QK); const bf16_t* Vt = (const bf16_t*)(ws + WS_VT); bf16_t* AO = (bf16_t*)(ws + WS_AO);
    float* tmp = (float*)(ws + WS_TMP) + (size_t)blockIdx.x * (64 * NTHR);
    const int tid = opaque_tid(), lane = tid & 63, wid = tid >> 6, r32 = lane & 31, hi = lane >> 5;
    const float lam = ((const float*)(ws + WS_LAM))[e];
    const float one_m = 1.f - (e == 0 ? 0.2f : 0.47071301834358416f);
    const float* sub_g = in_subg + e * 128;
    const int NU = 260 + 520;
    int u = blockIdx.x;
    while (u < NU) {
        AT_DEQ_ISSUE();
        if (u < 256 || (u >= 768 && u < 772)) {
            int qt, h;
            if (u < 256) { h = (u & 7) >> 1; qt = 2 * (u >> 3) + (u & 1); } else { qt = 64; h = u - 768; }
            const int q0 = 256 * qt, kt1 = qt < 64 ? 256 : 0, qtok = q0 + 32 * wid + r32;
            f32x16 o[4]; float m, l;
            attn_run<128, 0>(lds, QK, 2048, (2 * h) * 64, 1024 + (2 * h) * 64, Vt + (size_t)(h * 128) * TP, q0, 0, kt1, NEGBIG, 0.f, o, m, l);
            { const float inv = 1.f / l;
#pragma unroll
              for (int d = 0; d < 4; ++d)
#pragma unroll
                  for (int g = 0; g < 4; ++g) *G1((f32x4*)(tmp + tid * 64 + d * 16 + 4 * g)) = (f32x4){o[d][4 * g], o[d][4 * g + 1], o[d][4 * g + 2], o[d][4 * g + 3]} * inv; }
            attn_run<128, 0>(lds, QK, 2048, (2 * h + 1) * 64, 1024 + (2 * h + 1) * 64, Vt + (size_t)(h * 128) * TP, q0, 0, kt1, NEGBIG, 0.f, o, m, l);
            const float inv2 = lam / l; float ss = 0.f;
#pragma unroll
            for (int d = 0; d < 4; ++d) {
#pragma unroll
                for (int g = 0; g < 4; ++g) { const f32x4 t4 = *G1((const f32x4*)(tmp + tid * 64 + d * 16 + 4 * g));
#pragma unroll
                    for (int e = 0; e < 4; ++e) { const float v = t4[e] - o[d][4 * g + e] * inv2; o[d][4 * g + e] = v; ss += v * v; } }
                asm volatile("" ::: "memory");
            }
            ss += __shfl_xor(ss, 32);
            const float rstd = rsqrtf(ss * (1.f / 128.f) + NORM_EPS) * one_m;
            store_rows<4>(AO + (size_t)qtok * D + h * 128, o, rstd, sub_g, hi);
        } else {
            const int v = (u < 768) ? u - 256 : 512 + (u - 772), qt = v >> 3, head = v & 7;
            const int q0 = 256 * qt, qtok = q0 + 32 * wid + r32;
            int kt0 = 0, kt1 = 0;
            if (qt < 64) { const int r0 = 4 * qt; kt0 = min(max(r0 - 4, 0), 248); kt1 = min(max(r0 - 1, 0), 248) + 8; }
            { LAS float* rpbL = (LAS float*)(lds + AT_RPB); const float* rp = in_rpb + ((size_t)e * 8 + head) * (15 * 31);
              if (tid < 480) { const int r = tid >> 5, c = tid & 31; rpbL[tid] = (c < 31) ? G1(rp)[r * 31 + c] * LOG2E : 0.f; } }
            f32x16 o[2]; float m, l;
            attn_run<64, 1>(lds, QK, 2048, 512 + head * 64, 1536 + head * 64, Vt + (size_t)(512 + head * 64) * TP, q0, kt0, kt1, NEGBIG, 0.f, o, m, l);
            store_rows<2>(AO + (size_t)qtok * D + 512 + head * 64, o, 1.f / l, nullptr, hi);
        }
        AT_DEQ_TAKE();
    }
}
DI void attn_odd_phase(LAS unsigned char* lds, const float* in_sinks, unsigned char* ws, int od, unsigned* qctr) {
    const bf16_t* QK = (const bf16_t*)(ws + WS_QK); const bf16_t* Vt = (const bf16_t*)(ws + WS_VT); bf16_t* AO = (bf16_t*)(ws + WS_AO);
    const int tid = opaque_tid(), lane = tid & 63, wid = tid >> 6, r32 = lane & 31, hi = lane >> 5;
    const int NU = 65 * 16;
    int u = blockIdx.x;
    while (u < NU) {
        AT_DEQ_ISSUE();
        int qt = u >> 4, head = u & 15;
        if (u < 256 && gridDim.x == 256) {
            const int xcd = u & 7, i = u >> 3; head = 4 * (xcd & 3) + (i & 3); qt = 2 * (i >> 2) + (xcd >> 2); }
        const int kvh = head >> 2;
        const int q0 = 256 * qt, qtok = q0 + 32 * wid + r32;
        int kt0 = 0, kt1 = 0;
        if (qt < 64) { kt0 = max(4 * qt - 2, 0); kt1 = min(4 * qt + 6, 256); }
        const float sink = G1(in_sinks)[od * 16 + head] * LOG2E;
        f32x16 o[2]; float m, l;
        attn_run<64, 2>(lds, QK, 1280, head * 64, 1024 + kvh * 64, Vt + (size_t)(kvh * 64) * TP, q0, kt0, kt1, sink, 1.f, o, m, l);
        store_rows<2>(AO + (size_t)qtok * D + head * 64, o, 1.f / l, nullptr, hi);
        AT_DEQ_TAKE();
    }
}

DI void xpose_item(const float* W, int K, int N, bf16_t* WT, int mode, LAS float* scr, int item, int lane) {
    const int nblk = N / 32, kb = item / nblk, nb = item % nblk, k0 = 64 * kb, n0 = 32 * nb;
    float wv[32];
#pragma unroll
    for (int i = 0; i < 32; ++i) wv[i] = G1(W)[(size_t)(k0 + 2 * i + (lane >> 5)) * N + n0 + (lane & 31)];
#pragma unroll
    for (int i = 0; i < 32; ++i) scr[(2 * i + (lane >> 5)) * 33 + (lane & 31)] = wv[i];
    asm volatile("s_waitcnt lgkmcnt(0)" ::: "memory");
    const int c = lane & 7;
#pragma unroll
    for (int j = 0; j < 4; ++j) {
        const int nl = (lane >> 3) + 8 * j, n = n0 + nl; const LAS float* s = scr + (8 * c) * 33 + nl;
        int nd = n;
        if (mode == 1) { const int seg = n >> 9; nd = ((seg == 3) ? 4 : (seg == 4) ? 3 : seg) * 512 + (n & 511); }
        else if (mode == 2) nd = (n >> 4) * 32 + (n & 15);
        else if (mode == 3) nd = (n >> 4) * 32 + 16 + (n & 15);
        u32x4 o; o.x = pk_bf16(s[0 * 33], s[1 * 33]); o.y = pk_bf16(s[2 * 33], s[3 * 33]); o.z = pk_bf16(s[4 * 33], s[5 * 33]); o.w = pk_bf16(s[6 * 33], s[7 * 33]);
        *G1((u32x4*)(WT + (size_t)nd * K + k0 + 8 * c)) = o;
    }
    asm volatile("s_waitcnt lgkmcnt(0)" ::: "memory");
}

DI void prologue(LAS unsigned char* lds, const Args& a) {
    unsigned char* ws = a.ws;
    const int tid = opaque_tid(), lane = tid & 63, wave = tid >> 6, G = gridDim.x, gw = blockIdx.x * NWAVES + wave, NGW = G * NWAVES;
    float* mod = (float*)(ws + WS_MOD);
    __syncthreads();
    for (int bi = blockIdx.x; bi < 96; bi += G) {
        const int l = bi / 24, ch = bi % 24;
        LAS float* sv = (LAS float*)lds; LAS float* red = (LAS float*)(lds + 8192);
        for (int i = tid; i < 2048; i += NTHR) { const float v = (i < 1024) ? a.in[1][i] : a.in[3][i - 1024]; sv[i] = v / (1.f + expf(-v)); }
        __syncthreads();
        const float* W = a.in[4] + (size_t)l * 1024 * 6144 + ch * 256 + lane * 4;
        f32x4 ax = {0.f, 0.f, 0.f, 0.f}, ac = {0.f, 0.f, 0.f, 0.f};
        const int k0 = wave * 128;
#pragma unroll 8
        for (int k = 0; k < 128; ++k) { const f32x4 w = *G1((const f32x4*)(W + (size_t)(k0 + k) * 6144)); ax += w * sv[k0 + k]; ac += w * sv[1024 + k0 + k]; }
        *(LAS f32x4*)(red + (wave * 2 + 0) * 256 + lane * 4) = ax;
        *(LAS f32x4*)(red + (wave * 2 + 1) * 256 + lane * 4) = ac;
        __syncthreads();
        { const int g = tid >> 8, col = tid & 255; float s = a.in[5][l * 6144 + ch * 256 + col];
          for (int w = 0; w < 8; ++w) s += red[(w * 2 + g) * 256 + col];
          mod[(l * 2 + g) * 6144 + ch * 256 + col] = s; }
        __syncthreads();
    }
    for (int i = blockIdx.x * NTHR + tid; i < 4096; i += G * NTHR) {
        const int pos = i >> 4, fi = i & 15; const float inv = powf(10000.f, -(float)fi / 16.f), ang = (float)pos * inv;
        ((f32v2*)(ws + WS_ROPE))[i] = (f32v2){cosf(ang), sinf(ang)};
    }
    if (blockIdx.x == 0 && tid < 2) {
        const float* L = a.in[9] + tid * 256; float s1 = 0.f, s2 = 0.f;
        for (int i = 0; i < 64; ++i) { s1 += L[i] * L[64 + i]; s2 += L[128 + i] * L[192 + i]; }
        ((float*)(ws + WS_LAM))[tid] = expf(s1) - expf(s2) + (tid == 0 ? 0.2f : 0.47071301834358416f);
    }
    LAS float* scr = (LAS float*)(lds + wave * 8448);
    bf16_t* WinAB = (bf16_t*)(ws + WS_WINAB); bf16_t* WoutAB = (bf16_t*)(ws + WS_WOUTAB); bf16_t* WinC = (bf16_t*)(ws + WS_WINC); bf16_t* WoutC = (bf16_t*)(ws + WS_WOUTC);
    bf16_t* W13 = (bf16_t*)(ws + WS_W13); bf16_t* W2 = (bf16_t*)(ws + WS_W2);
    constexpr int NTOT = 3072 + 1024 + 1536 + 1024 + 5632 + 5632 + 5632;
    for (int it = gw; it < NTOT; it += NGW) {
        int r = it;
        if (r < 3072) { const int e = r / 1536; xpose_item(a.in[7] + (size_t)e * 1024 * 3072, 1024, 3072, WinAB + (size_t)e * 3072 * 1024, 1, scr, r % 1536, lane); continue; } r -= 3072;
        if (r < 1024) { const int e = r / 512; xpose_item(a.in[8] + (size_t)e * 1024 * 1024, 1024, 1024, WoutAB + (size_t)e * 1024 * 1024, 0, scr, r % 512, lane); continue; } r -= 1024;
        if (r < 1536) { const int e = r / 768; xpose_item(a.in[12] + (size_t)e * 1024 * 1536, 1024, 1536, WinC + (size_t)e * 1536 * 1024, 0, scr, r % 768, lane); continue; } r -= 1536;
        if (r < 1024) { const int e = r / 512; xpose_item(a.in[13] + (size_t)e * 1024 * 1024, 1024, 1024, WoutC + (size_t)e * 1024 * 1024, 0, scr, r % 512, lane); continue; } r -= 1024;
        if (r < 5632) { const int l = r / 1408; xpose_item(a.in[15] + (size_t)l * 1024 * FFN, 1024, FFN, W13 + (size_t)l * FFN2 * 1024, 2, scr, r % 1408, lane); continue; } r -= 5632;
        if (r < 5632) { const int l = r / 1408; xpose_item(a.in[16] + (size_t)l * 1024 * FFN, 1024, FFN, W13 + (size_t)l * FFN2 * 1024, 3, scr, r % 1408, lane); continue; } r -= 5632;
        { const int l = r / 1408; xpose_item(a.in[17] + (size_t)l * FFN * 1024, FFN, 1024, W2 + (size_t)l * 1024 * FFN, 0, scr, r % 1408, lane); }
    }
}

DI void norm_phase(unsigned char* ws, const float* src_x, const float* src_c  , const float* g, const float* modl  , int shift_i, int npart  ) {
    bf16_t* H = (bf16_t*)(ws + WS_H);
    const int tid = opaque_tid(), lane = tid & 63, wave = tid >> 6, gw = blockIdx.x * NWAVES + wave, NGW = gridDim.x * NWAVES;
    for (int r = gw; r < T; r += NGW) {
        const float* xr = (r < SEQ ? src_x + (size_t)r * D : src_c + (size_t)(r - SEQ) * D) + 4 * lane; const float* md = modl + (r >= SEQ ? 6144 : 0) + shift_i * 1024 + 4 * lane;
        f32x4 v[4]; float ss = 0.f;
#pragma unroll
        for (int j = 0; j < 4; ++j) v[j] = *G1((const f32x4*)(xr + 256 * j));
        if (r >= SEQ && npart > 0) {
            const float* pr = (const float*)(ws + WS_TMP) + (size_t)(r - SEQ) * D + 4 * lane;
            for (int s = 0; s < npart; ++s)
#pragma unroll
                for (int j = 0; j < 4; ++j) v[j] += *G1((const f32x4*)(pr + (size_t)s * (NCTX * D) + 256 * j));
#pragma unroll
            for (int j = 0; j < 4; ++j) *G1((f32x4*)((float*)(ws + WS_X) + (size_t)r * D + 4 * lane + 256 * j)) = v[j];
        }
#pragma unroll
        for (int j = 0; j < 4; ++j) ss += (v[j].x * v[j].x + v[j].y * v[j].y) + (v[j].z * v[j].z + v[j].w * v[j].w);
        const float rstd = rsqrtf(wave_sum(ss) * (1.f / D) + NORM_EPS);
#pragma unroll
        for (int j = 0; j < 4; ++j) {
            const f32x4 gg = *G1((const f32x4*)(g + 4 * lane + 256 * j)), sh = *G1((const f32x4*)(md + 256 * j)), sc = *G1((const f32x4*)(md + 1024 + 256 * j));
            const f32x4 y = (v[j] * rstd * gg) * (sc + 1.f) + sh;
            u32x2 w; w.x = pk_bf16(y[0], y[1]); w.y = pk_bf16(y[2], y[3]);
            *G1((u32x2*)(H + (size_t)r * D + 4 * lane + 256 * j)) = w;
        }
    }
}
DI void final_norm(const Args& a) {
    const float* X = (const float*)(a.ws + WS_X); const float* g = a.in[18];
    const int tid = opaque_tid(), lane = tid & 63, wave = tid >> 6, gw = blockIdx.x * NWAVES + wave, NGW = gridDim.x * NWAVES;
    for (int r = gw; r < SEQ; r += NGW) {
        const float* xr = X + (size_t)r * D + 4 * lane;
        f32x4 v[4]; float ss = 0.f;
#pragma unroll
        for (int j = 0; j < 4; ++j) { v[j] = *G1((const f32x4*)(xr + 256 * j)); ss += (v[j].x * v[j].x + v[j].y * v[j].y) + (v[j].z * v[j].z + v[j].w * v[j].w); }
        const float rstd = rsqrtf(wave_sum(ss) * (1.f / D) + NORM_EPS);
#pragma unroll
        for (int j = 0; j < 4; ++j) { const f32x4 gg = *G1((const f32x4*)(g + 4 * lane + 256 * j)); *G1((f32x4*)(a.out + (size_t)r * D + 4 * lane + 256 * j)) = v[j] * rstd * gg; }
    }
}

#define XB_TMO      128
#define XB_XCNT(j)  (256  + 64 * (j))
#define XB_XSUB(j)  (1280 + 64 * (j))
#define XB_XGEN(j)  (2304 + 64 * (j))
#define XB_TOP      3328
#define XB_TOPGEN   3392
#define XCD_BAR_WORDS 3456
#define XB_SPIN_CAP (1u << 18)

__device__ __forceinline__ unsigned xb_ld(unsigned* p)              { return __hip_atomic_load(p, __ATOMIC_RELAXED, __HIP_MEMORY_SCOPE_AGENT); }
__device__ __forceinline__ unsigned xb_add(unsigned* p, unsigned v) { return __hip_atomic_fetch_add(p, v, __ATOMIC_RELAXED, __HIP_MEMORY_SCOPE_AGENT); }
__device__ __forceinline__ unsigned xb_xcc_id() { return (unsigned)__builtin_amdgcn_s_getreg((3 << 11) | 20) & 0xFu; }
#define XB_SPIN(cond, bar) do { unsigned _sp = 0; while (cond) { __builtin_amdgcn_s_sleep(1); \
    if ((++_sp & 255u) == 0u) { if (xb_ld(&(bar)[XB_TMO])) break; if (_sp > XB_SPIN_CAP) { atomicAdd(&(bar)[XB_TMO], 1u); break; } } } } while (0)

struct XcdBarrier {
    unsigned* bar; unsigned x;
    volatile LAS unsigned* st;
};

__device__ __forceinline__ XcdBarrier xcd_barrier_post(unsigned* bar, volatile LAS unsigned* st) {
    XcdBarrier b; b.bar = bar; b.x = xb_xcc_id(); b.st = st;
    if (threadIdx.x == 0) (void)xb_add(&bar[XB_XCNT(b.x)], 1u);
    return b;
}
__device__ __forceinline__ void xcd_barrier_complete(unsigned* bar, unsigned x, unsigned& nloc, unsigned& nx) {
    const unsigned G = gridDim.x * gridDim.y * gridDim.z;
    unsigned sum, cnt, mine, sp = 0u;
    for (;;) {
        sum = 0u; cnt = 0u; mine = 0u;
#pragma unroll
        for (unsigned j = 0; j < 16; ++j) { const unsigned c = xb_ld(&bar[XB_XCNT(j)]); sum += c; cnt += (c > 0u) ? 1u : 0u; mine = (j == x) ? c : mine; }
        if (sum == G) break;
        __builtin_amdgcn_s_sleep(1);
        if ((++sp & 255u) == 0u) { if (xb_ld(&bar[XB_TMO])) break; if (sp > XB_SPIN_CAP) { atomicAdd(&bar[XB_TMO], 1u); break; } }
    }
    nloc = mine > 0u ? mine : 1u; nx = cnt > 0u ? cnt : 1u;
}

__device__ __forceinline__ void xcd_barrier(const XcdBarrier& b) {
    asm volatile("s_waitcnt vmcnt(0)" ::: "memory");
    __syncthreads();
    if (threadIdx.x == 0) {
        unsigned* bar = b.bar;
        __builtin_amdgcn_s_waitcnt(0);
        unsigned nloc = b.st[0], nx = b.st[1];
        if (nloc == 0u) { xcd_barrier_complete(bar, b.x, nloc, nx); b.st[0] = nloc; b.st[1] = nx; }
        const unsigned old = xb_add(&bar[XB_XSUB(b.x)], 1u);
        const unsigned gen = old / nloc;
        if (old + 1u == (gen + 1u) * nloc) {
            __builtin_amdgcn_fence(__ATOMIC_RELEASE, "agent");
            asm volatile("s_waitcnt vmcnt(0)" ::: "memory");
            const unsigned og = xb_add(&bar[XB_TOP], 1u);
            const unsigned tg = og / nx;
            if (og + 1u == (tg + 1u) * nx) xb_add(&bar[XB_TOPGEN], 1u);
            else XB_SPIN(xb_ld(&bar[XB_TOPGEN]) == tg, bar);
            __builtin_amdgcn_fence(__ATOMIC_ACQUIRE, "agent");
            xb_add(&bar[XB_XGEN(b.x)], 1u);
            asm volatile("s_waitcnt vmcnt(0)" ::: "memory");
        } else {
            XB_SPIN(xb_ld(&bar[XB_XGEN(b.x)]) == gen, bar);
            __builtin_amdgcn_fence(__ATOMIC_ACQUIRE, "agent");
            asm volatile("s_waitcnt vmcnt(0)" ::: "memory");
        }
    }
    __syncthreads();
}

#ifndef MK_SPLIT
#define MK_SPLIT 0
#endif
constexpr int N_PHASES = 2 + 7 * DEPTH;
#ifndef REP_ATT
#define REP_ATT 1
#endif
#ifndef REP_G2
#define REP_G2 1
#endif
#ifndef REP_G4
#define REP_G4 1
#endif
#ifndef REP_G
#define REP_G 1
#endif
#ifndef REP_NORM
#define REP_NORM 1
#endif
#ifndef REP_SYNC
#define REP_SYNC 1
#endif
#ifndef REP_PRO
#define REP_PRO 1
#endif

__global__ void __launch_bounds__(NTHR) mega_fwd(Args a) {
    extern __shared__ __attribute__((aligned(16))) unsigned char lds_raw[];
    LAS unsigned char* lds = (LAS unsigned char*)lds_raw;
    cg::grid_group grid = cg::this_grid();
    { volatile LAS unsigned* misc = (volatile LAS unsigned*)(lds + LDS_MISC); if (threadIdx.x < 16) misc[threadIdx.x] = 0u; }
    __syncthreads();
    XcdBarrier bar = xcd_barrier_post((unsigned*)(a.ws + WS_BAR), (volatile LAS unsigned*)(lds + LDS_MISC));
    const int lo = a.ph_lo, hi = a.ph_hi;
    int ph = 0;
#define PH_BEGIN if (ph >= lo && ph < hi) {
#define PH_END   if (ph + 1 < hi) { for (int rs_ = 0; rs_ < REP_SYNC; ++rs_) { if (lo < 0) grid.sync(); else xcd_barrier(bar); }     } } ++ph;
    PH_BEGIN for (int rp_ = 0; rp_ < REP_PRO; ++rp_) prologue(lds, a); PH_END

    for (int l = 0; l < DEPTH; ++l) {
        unsigned char* ws = a.ws; asm volatile("" : "+s"(ws));
        const float* in6 = a.in[6]; const float* in10 = a.in[10]; const float* in11 = a.in[11]; const float* in14 = a.in[14];
        asm volatile("" : "+s"(in6), "+s"(in10), "+s"(in11), "+s"(in14));
        const float* mod = (const float*)(ws + WS_MOD);
        bf16_t* H = (bf16_t*)(ws + WS_H); bf16_t* AO = (bf16_t*)(ws + WS_AO); bf16_t* QK = (bf16_t*)(ws + WS_QK); bf16_t* Vt = (bf16_t*)(ws + WS_VT); bf16_t* HID = (bf16_t*)(ws + WS_HID);
        float* X = (float*)(ws + WS_X);
        const int odd = l & 1, idx = l >> 1;
        const int Mr = (l == DEPTH - 1) ? SEQ : T;
        const float* modl = mod + (size_t)l * 2 * 6144;
        PH_BEGIN for (int rn_ = 0; rn_ < REP_NORM; ++rn_) norm_phase(ws, l == 0 ? a.in[0] : (const float*)X, l == 0 ? a.in[2] : (const float*)X + (size_t)SEQ * D, in6 + (l * 2 + 0) * D, modl, 0, l > 0 ? 11 : 0); PH_END
        PH_BEGIN {
            const bf16_t* W = odd ? (const bf16_t*)(ws + WS_WINC) + (size_t)idx * 1536 * 1024 : (const bf16_t*)(ws + WS_WINAB) + (size_t)idx * 3072 * 1024;
            const int N = odd ? 1536 : 3072;
            pg8::Gemm g{H, W, T, N, D, D}; pg8::StaticOrder S; S.init(T, N, gridDim.x, (int)blockIdx.x);
            EpiQKV E{QK, odd ? 1280 : 2048, Vt, 4, odd ? 5 : 8, (const f32v2*)(ws + WS_ROPE), odd ? 0x1fu : 0x33u};
            for (int rg_ = 0; rg_ < REP_G; ++rg_) pg8::gemm_phase<EpiQKV, pg8::StaticOrder, true, true>(lds, g, S, E);
        } PH_END
        PH_BEGIN
        for (int rep = 0; rep < REP_ATT; ++rep) { unsigned* qctr = (unsigned*)(ws + WS_BAR + 24576) + (l * REP_ATT + rep) * 64; if (odd) attn_odd_phase(lds, in14, ws, idx, qctr); else attn_even_phase(lds, in10, in11, ws, idx, qctr); }
        PH_END
        PH_BEGIN {
            const bf16_t* W = odd ? (const bf16_t*)(ws + WS_WOUTC) + (size_t)idx * 1024 * 1024 : (const bf16_t*)(ws + WS_WOUTAB) + (size_t)idx * 1024 * 1024;
            pg8::Gemm g{AO, W, SEQ, D, D, D}; pg8::StaticOrder S; S.init(SEQ, D, gridDim.x, (int)blockIdx.x);
            EpiResid E{X, modl + 2 * 1024, modl + 6144 + 2 * 1024, l == 0 ? a.in[0] : (const float*)X};
            pg8::gemm_phase<EpiResid, pg8::StaticOrder, true, true>(lds, g, S, E);
            if (l < DEPTH - 1) {
                pg8::Gemm gc{AO + (size_t)SEQ * D, W, NCTX, D, 256, D}; CtxSplit Sc{4, (int)blockIdx.x};
                EpiPartial Ec{(float*)(ws + WS_TMP), modl + 6144 + 2 * 1024};
                pg8::gemm_phase<EpiPartial, CtxSplit, true, true>(lds, gc, Sc, Ec);
            }
#if REP_G2 > 1
            { EpiResid Ez{X, (const float*)(ws + WS_ZERO), (const float*)(ws + WS_ZERO), (const float*)X}; pg8::gemm_phase<EpiResid, pg8::StaticOrder, true, true>(lds, g, S, Ez); }
#endif
        } PH_END
        PH_BEGIN for (int rn_ = 0; rn_ < REP_NORM; ++rn_) norm_phase(ws, (const float*)X, l == 0 ? a.in[2] : (const float*)X + (size_t)SEQ * D, in6 + (l * 2 + 1) * D, modl, 3, l < DEPTH - 1 ? 4 : 0); PH_END
        PH_BEGIN {
            pg8::Gemm g{H, (const bf16_t*)(ws + WS_W13) + (size_t)l * FFN2 * 1024, Mr, FFN2, D, D}; pg8::StaticOrder S; S.init(Mr, FFN2, gridDim.x, (int)blockIdx.x);
            EpiSwiGLU E{HID};
            for (int rg_ = 0; rg_ < REP_G; ++rg_) pg8::gemm_phase<EpiSwiGLU, pg8::StaticOrder, true, true>(lds, g, S, E);
        } PH_END
        PH_BEGIN {
            pg8::Gemm g{HID, (const bf16_t*)(ws + WS_W2) + (size_t)l * 1024 * FFN, SEQ, D, FFN, FFN}; pg8::StaticOrder S; S.init(SEQ, D, gridDim.x, (int)blockIdx.x);
            EpiResid E{X, modl + 5 * 1024, modl + 6144 + 5 * 1024, (const float*)X};
            pg8::gemm_phase<EpiResid, pg8::StaticOrder, true, true>(lds, g, S, E);
            if (l < DEPTH - 1) {
                pg8::Gemm gc{HID + (size_t)SEQ * FFN, (const bf16_t*)(ws + WS_W2) + (size_t)l * 1024 * FFN, NCTX, D, 256, FFN}; CtxSplit Sc{11, (int)blockIdx.x};
                EpiPartial Ec{(float*)(ws + WS_TMP), modl + 6144 + 5 * 1024};
                pg8::gemm_phase<EpiPartial, CtxSplit, true, true>(lds, gc, Sc, Ec);
            }
#if REP_G4 > 1
            { EpiResid Ez{X, (const float*)(ws + WS_ZERO), (const float*)(ws + WS_ZERO), (const float*)X}; pg8::gemm_phase<EpiResid, pg8::StaticOrder, true, true>(lds, g, S, Ez); }
#endif
        } PH_END
    }
    PH_BEGIN final_norm(a); PH_END
#undef PH_BEGIN
#undef PH_END
}

extern "C" void kernel_launch(void* const* d_in, const int* in_sizes, int n_in, void* d_out, int out_size, void* d_ws, size_t ws_size, hipStream_t stream) {
    static int grid = 0;
    if (grid == 0) {
        if (n_in != 19 || in_sizes[0] != SEQ * D || out_size != SEQ * D || ws_size < WS_END) { fprintf(stderr, "kernel_launch: unexpected shapes (n_in %d, x %d, out %d, ws %zu)\n", n_in, n_in > 0 ? in_sizes[0] : -1, out_size, ws_size); grid = -1; return; }
        int dev = 0, cus = 0, per_cu = 0;
        hipGetDevice(&dev); hipDeviceGetAttribute(&cus, hipDeviceAttributeMultiprocessorCount, dev);
        if (hipFuncSetAttribute((const void*)mega_fwd, hipFuncAttributeMaxDynamicSharedMemorySize, LDS_BYTES) != hipSuccess) { fprintf(stderr, "kernel_launch: hipFuncSetAttribute failed\n"); grid = -1; return; }
        if (hipOccupancyMaxActiveBlocksPerMultiprocessor(&per_cu, (const void*)mega_fwd, NTHR, LDS_BYTES) != hipSuccess || per_cu < 1) { fprintf(stderr, "kernel_launch: occupancy query says %d\n", per_cu); per_cu = 1; }
        (void)hipGetLastError();
        grid = cus * 1;
    }
    if (grid < 0) return;
    if (hipMemsetAsync((char*)d_ws + WS_BAR, 0, BAR_ZERO_BYTES, stream) != hipSuccess) { fprintf(stderr, "kernel_launch: memset of barrier words failed\n"); return; }
    Args a{};
    for (int i = 0; i < 19; ++i) a.in[i] = (const float*)d_in[i];
    a.out = (float*)d_out; a.ws = (unsigned char*)d_ws;
#if MK_SPLIT
    for (int p = 0; p < N_PHASES; ++p) { a.ph_lo = p; a.ph_hi = p + 1; hipLaunchKernelGGL(mega_fwd, dim3(grid), dim3(NTHR), LDS_BYTES, stream, a); }
#else
    a.ph_lo = 0; a.ph_hi = N_PHASES;
    void* args[] = {&a};
    hipError_t e = hipLaunchCooperativeKernel((const void*)mega_fwd, dim3(grid), dim3(NTHR), args, LDS_BYTES, stream);
    if (e != hipSuccess) fprintf(stderr, "cooperative launch failed: %s (grid %d)\n", hipGetErrorString(e), grid);
#endif
}
```

```cpp
#include <hip/hip_runtime.h>
#include <hip/hip_cooperative_groups.h>
#include <cstdio>
#include <cstdint>
namespace cg = cooperative_groups;
namespace pg8 {
#define PG8_LAS __attribute__((address_space(3)))
typedef unsigned short bf16_t;
typedef short bf16x8 __attribute__((ext_vector_type(8)));
typedef float f32x4 __attribute__((ext_vector_type(4)));
typedef unsigned u32x4 __attribute__((ext_vector_type(4)));
constexpr int BM = 256, BK = 64, HALF = 128, HTB = HALF * BK * 2  , STAGE_BYTES = 8 * HTB, NXCD = 8, WGM = 4;

__host__ __device__ __forceinline__ int lds_byte(int r, int c) { const int st = (r >> 4) * 2 + (c >> 5), rr = r & 15, cc = c & 31, ob = rr * 64 + cc * 2; return st * 1024 + (ob ^ (((ob >> 9) & 1) << 5)); }
__host__ __device__ __forceinline__ void stage_rc(int b, int& R, int& C) { const int st = b / 1024, sb = b % 1024, swz = sb ^ (((sb >> 9) & 1) << 5); R = (st >> 1) * 16 + swz / 64; C = (st & 1) * 32 + (swz % 64) / 2; }
__host__ __device__ __forceinline__ int perm32(int rho) { const int n = rho >> 4, i = rho & 15; return 8 * (i >> 2) + 4 * n + (i & 3); }

struct Unit { int pm, pn, ko; };
struct Gemm { const bf16_t* A; const bf16_t* Bt; int M, N, K, ld; };

struct StaticOrder {
    int nM, nN, nwg, G, c;
    __host__ __device__ void init(int M, int N, int G_, int c_) { nM = M / BM; nN = N / BM; nwg = nM * nN; G = G_; c = c_; }
    __host__ __device__ bool next(int i, Unit& u) const {
        const long L = (long)i * G + c; if (L >= nwg) return false;
        int wgid = (int)L; { const int q = nwg / NXCD, r = nwg % NXCD, xcd = wgid % NXCD, off = wgid / NXCD; wgid = (xcd < r ? xcd * (q + 1) : r * (q + 1) + (xcd - r) * q) + off; }
        const int nig = WGM * nN, gid = wgid / nig, fm = gid * WGM, gsz = (nM - fm) < WGM ? (nM - fm) : WGM;
        u.pm = fm + ((wgid % nig) % gsz); u.pn = (wgid % nig) / gsz; u.ko = 0; return true;
    }
    __device__ __forceinline__ void a_ready(const Unit&) const {}
    __device__ __forceinline__ void done(const Unit&) const {}
};

__device__ __forceinline__ unsigned cvt_pk_bf16(float lo, float hi) { unsigned r; asm volatile("v_cvt_pk_bf16_f32 %0, %1, %2" : "=v"(r) : "v"(lo), "v"(hi)); return r; }
typedef float f32x2 __attribute__((ext_vector_type(2)));
template <class Epi, class Sched, bool ALIGN_EPI = false, bool SP2 = false>
__device__ __forceinline__ void gemm_phase(PG8_LAS unsigned char* lds, const Gemm g, const Sched& S, const Epi& E) {
    int tid_ = threadIdx.x; asm volatile("" : "+v"(tid_));
    const int tid = tid_, wid = __builtin_amdgcn_readfirstlane(tid >> 6), lane = tid & 63, wr = wid >> 2, wc = wid & 3, fr = lane & 15, fq = lane >> 4;
    const int K = g.ld, nt = g.K / BK;
    unsigned voffA[2], voffB[2];
#pragma unroll
    for (int i = 0; i < 2; ++i) { int R, C; stage_rc(tid * 16 + i * 8192, R, C); const int Rb = Epi::PERM ? ((R & ~31) + perm32(R & 31)) : R;
        voffA[i] = (unsigned)(R * K + C) * 2u; voffB[i] = (unsigned)(Rb * K + C) * 2u; }
    const size_t kstep = (size_t)(BK * 2);
    const size_t hstep = (size_t)HALF * K * 2;
    const size_t tstep = 2 * hstep;
    const unsigned ldsw = (unsigned)wid * 1024u;
    const int aoff = lds_byte(wr * 64 + fr, fq * 8), boff = lds_byte(wc * 32 + fr, fq * 8);
#define PG8_SA(b, h) (((b) * 2 + (h)) * HTB)
#define PG8_SB(b, h) ((4 + (b) * 2 + (h)) * HTB)
#define PG8_STAGE(bufoff, gbase, voff) do { _Pragma("unroll") for (int _i = 0; _i < 2; ++_i) \
        __builtin_amdgcn_global_load_lds((const unsigned*)((const char*)(gbase) + (voff)[_i]), (PG8_LAS unsigned*)(lds + (bufoff) + ldsw + _i * 8192), 16, 0, 0); } while (0)
#define PG8_LDA(dst, b, h) do { _Pragma("unroll") for (int m = 0; m < 4; ++m) _Pragma("unroll") for (int k = 0; k < 2; ++k) dst[m][k] = *(const PG8_LAS bf16x8*)(lds + PG8_SA(b, h) + aoff + m * 2048 + k * 1024); } while (0)
#define PG8_LDB(dst, b, h) do { _Pragma("unroll") for (int n = 0; n < 2; ++n) _Pragma("unroll") for (int k = 0; k < 2; ++k) dst[n][k] = *(const PG8_LAS bf16x8*)(lds + PG8_SB(b, h) + boff + n * 2048 + k * 1024); } while (0)
#define PG8_MMA(ai, bj, At, Bt) do { __builtin_amdgcn_s_setprio(1); _Pragma("unroll") for (int m = 0; m < 4; ++m) _Pragma("unroll") for (int n = 0; n < 2; ++n) _Pragma("unroll") for (int k = 0; k < 2; ++k) \
        acc[ai][bj][m][n] = __builtin_amdgcn_mfma_f32_16x16x32_bf16(Bt[n][k], At[m][k], acc[ai][bj][m][n], 0, 0, 0); __builtin_amdgcn_s_setprio(0); } while (0)
#define PG8_WAIT_V(n) asm volatile("s_waitcnt vmcnt(" #n ")" ::: "memory")
#define PG8_WAIT_L(n) asm volatile("s_waitcnt lgkmcnt(" #n ")" ::: "memory")
#define PG8_BAR __builtin_amdgcn_s_barrier()
#define PG8_SCHED __builtin_amdgcn_sched_barrier(0)
    Unit cur, nxt; int ui = 0;
    if (!S.next(0, cur)) return;
    f32x4 acc[2][2][4][2];
#pragma unroll
    for (int a = 0; a < 2; ++a)
#pragma unroll
        for (int b = 0; b < 2; ++b)
#pragma unroll
            for (int m = 0; m < 4; ++m)
#pragma unroll
                for (int n = 0; n < 2; ++n) acc[a][b][m][n] = (f32x4){0.f, 0.f, 0.f, 0.f};
    bf16x8 At[4][2], B0[2][2], B1[2][2];
    const char* cA = (const char*)g.A + (size_t)cur.pm * tstep + (size_t)cur.ko * 2; const char* cB = (const char*)g.Bt + (size_t)cur.pn * tstep + (size_t)cur.ko * 2;
    S.a_ready(cur);
    if constexpr (SP2) {
        PG8_STAGE(PG8_SB(0, 0), cB, voffB); PG8_STAGE(PG8_SB(0, 1), cB + hstep, voffB); PG8_STAGE(PG8_SA(0, 0), cA, voffA); PG8_STAGE(PG8_SA(0, 1), cA + hstep, voffA);
        if (wr == 1) PG8_BAR;
        PG8_WAIT_V(2); PG8_BAR;
        PG8_STAGE(PG8_SB(1, 0), cB + kstep, voffB); PG8_STAGE(PG8_SA(1, 0), cA + kstep, voffA); PG8_STAGE(PG8_SB(1, 1), cB + hstep + kstep, voffB);
        PG8_WAIT_V(6); PG8_BAR;
    } else {
        PG8_STAGE(PG8_SB(0, 0), cB, voffB); PG8_STAGE(PG8_SA(0, 0), cA, voffA); PG8_STAGE(PG8_SB(0, 1), cB + hstep, voffB); PG8_STAGE(PG8_SA(0, 1), cA + hstep, voffA);
        if (wr == 1) PG8_BAR;
        PG8_WAIT_V(4); PG8_BAR;
        PG8_STAGE(PG8_SB(1, 0), cB + kstep, voffB); PG8_STAGE(PG8_SA(1, 0), cA + kstep, voffA); PG8_STAGE(PG8_SB(1, 1), cB + hstep + kstep, voffB);
        PG8_WAIT_V(6); PG8_BAR;
    }
    for (;;) {
        const bool has_next = S.next(ui + 1, nxt);
        const char* nA = has_next ? (const char*)g.A + (size_t)nxt.pm * tstep + (size_t)nxt.ko * 2 : cA; const char* nB = has_next ? (const char*)g.Bt + (size_t)nxt.pn * tstep + (size_t)nxt.ko * 2 : cB;
        for (int t = 0; t < nt; t += 2) {
            const bool last = (t == nt - 2);
            const char* a1 = cA + (size_t)(t + 1) * kstep;
            const char* a2 = last ? nA : cA + (size_t)(t + 2) * kstep; const char* b2 = last ? nB : cB + (size_t)(t + 2) * kstep;
            const char* a3 = a2 + kstep; const char* b3 = b2 + kstep;
            if (last && has_next) S.a_ready(nxt);
            if constexpr (SP2) {
            PG8_LDB(B0, 0, 0); PG8_LDB(B1, 0, 1); PG8_SCHED; PG8_LDA(At, 0, 0); PG8_STAGE(PG8_SA(1, 1), a1 + hstep, voffA);
            PG8_WAIT_V(8); PG8_WAIT_L(0); PG8_BAR; PG8_MMA(0, 0, At, B0); PG8_MMA(0, 1, At, B1); PG8_BAR; PG8_SCHED;
            PG8_LDA(At, 0, 1); PG8_STAGE(PG8_SB(0, 0), b2, voffB); PG8_STAGE(PG8_SB(0, 1), b2 + hstep, voffB); PG8_STAGE(PG8_SA(0, 0), a2, voffA);
            PG8_WAIT_V(8); PG8_WAIT_L(0); PG8_BAR; PG8_MMA(1, 0, At, B0); PG8_MMA(1, 1, At, B1); PG8_BAR; PG8_SCHED;
            PG8_LDB(B0, 1, 0); PG8_LDB(B1, 1, 1); PG8_SCHED; PG8_LDA(At, 1, 0); PG8_STAGE(PG8_SA(0, 1), a2 + hstep, voffA);
            PG8_WAIT_V(8); PG8_WAIT_L(0); PG8_BAR; PG8_MMA(0, 0, At, B0); PG8_MMA(0, 1, At, B1); PG8_BAR; PG8_SCHED;
            PG8_LDA(At, 1, 1); PG8_STAGE(PG8_SB(1, 0), b3, voffB); PG8_STAGE(PG8_SB(1, 1), b3 + hstep, voffB); PG8_STAGE(PG8_SA(1, 0), a3, voffA);
            PG8_WAIT_V(8); PG8_WAIT_L(0); PG8_BAR; PG8_MMA(1, 0, At, B0); PG8_MMA(1, 1, At, B1); PG8_BAR; PG8_SCHED;
            } else {
            PG8_LDB(B0, 0, 0); PG8_SCHED; PG8_LDA(At, 0, 0); PG8_STAGE(PG8_SA(1, 1), a1 + hstep, voffA);
            PG8_WAIT_L(8); PG8_BAR; PG8_WAIT_L(0); PG8_MMA(0, 0, At, B0); PG8_BAR; PG8_SCHED;
            PG8_LDB(B1, 0, 1); PG8_STAGE(PG8_SB(0, 0), b2, voffB);
            PG8_BAR; PG8_WAIT_L(0); PG8_MMA(0, 1, At, B1); PG8_BAR;
            PG8_LDA(At, 0, 1); PG8_STAGE(PG8_SA(0, 0), a2, voffA);
            PG8_BAR; PG8_WAIT_L(0); PG8_MMA(1, 0, At, B0); PG8_BAR; PG8_SCHED;
            PG8_STAGE(PG8_SB(0, 1), b2 + hstep, voffB);
            PG8_WAIT_V(6); PG8_BAR; PG8_MMA(1, 1, At, B1); PG8_BAR;
            PG8_LDB(B0, 1, 0); PG8_SCHED; PG8_LDA(At, 1, 0); PG8_STAGE(PG8_SA(0, 1), a2 + hstep, voffA);
            PG8_WAIT_L(8); PG8_BAR; PG8_WAIT_L(0); PG8_MMA(0, 0, At, B0); PG8_BAR; PG8_SCHED;
            PG8_LDB(B1, 1, 1); PG8_STAGE(PG8_SB(1, 0), b3, voffB);
            PG8_BAR; PG8_WAIT_L(0); PG8_MMA(0, 1, At, B1); PG8_BAR;
            PG8_LDA(At, 1, 1); PG8_STAGE(PG8_SA(1, 0), a3, voffA);
            PG8_BAR; PG8_WAIT_L(0); PG8_MMA(1, 0, At, B0); PG8_BAR; PG8_SCHED;
            PG8_STAGE(PG8_SB(1, 1), b3 + hstep, voffB);
            PG8_WAIT_V(6); PG8_BAR; PG8_MMA(1, 1, At, B1); PG8_BAR;
            }
        }
        if constexpr (ALIGN_EPI) { if (wr == 0) PG8_BAR; }
        if constexpr (!Epi::AFTER_DRAIN) { E(acc, cur, wr, wc, fr, fq); S.done(cur); }
        if (!has_next) break;
#pragma unroll
        for (int a = 0; a < 2; ++a)
#pragma unroll
            for (int b = 0; b < 2; ++b)
#pragma unroll
                for (int m = 0; m < 4; ++m)
#pragma unroll
                    for (int n = 0; n < 2; ++n) acc[a][b][m][n] = (f32x4){0.f, 0.f, 0.f, 0.f};
        cur = nxt; cA = nA; cB = nB; ++ui;
        if constexpr (ALIGN_EPI) { if (wr == 1) PG8_BAR; }
    }
    PG8_WAIT_V(0);
    if constexpr (!ALIGN_EPI) { if (wr == 0) PG8_BAR; }
    PG8_BAR;
    if constexpr (Epi::AFTER_DRAIN) { E.fused(acc, cur, wr, wc, fr, fq, lds, wid, lane); S.done(cur); }
#undef PG8_SA
#undef PG8_SB
#undef PG8_STAGE
#undef PG8_LDA
#undef PG8_LDB
#undef PG8_MMA
#undef PG8_WAIT_V
#undef PG8_WAIT_L
#undef PG8_BAR
#undef PG8_SCHED
}
}

using pg8::bf16_t; using pg8::bf16x8; using pg8::f32x4; using pg8::u32x4;
#define LAS __attribute__((address_space(3)))
#define DI __device__ __forceinline__
#define GAS __attribute__((address_space(1)))
#define G1(p) ((GAS __typeof__(*(p))*)(p))
typedef float f32x16 __attribute__((ext_vector_type(16)));
typedef unsigned u32x2 __attribute__((ext_vector_type(2)));
typedef short s16x4 __attribute__((ext_vector_type(4)));
typedef __bf16 bf16v2 __attribute__((ext_vector_type(2)));
typedef float f32v2 __attribute__((ext_vector_type(2)));
#define MFMA32(a, b, c) __builtin_amdgcn_mfma_f32_32x32x16_bf16((a), (b), (c), 0, 0, 0)

constexpr int D = 1024, SEQ = 16384, NCTX = 256, T = SEQ + NCTX, DEPTH = 4, FFN = 2816, FFN2 = 2 * FFN, TP = T;
constexpr int NWAVES = 8, NTHR = 512;
constexpr float NORM_EPS = 1e-6f, LOG2E = 1.4426950408889634f, QSCALE = 0.125f * LOG2E, NEGBIG = -1e30f;
constexpr int LDS_BYTES = 135168, LDS_MISC = 132096;

constexpr size_t MiB = 1u << 20;
constexpr size_t WS_ROPE = 0, WS_LAM = 64 * 1024, WS_MOD = 128 * 1024, WS_BAR = 512 * 1024, BAR_ZERO_BYTES = 32768, WS_ZERO = WS_BAR + 16384;
constexpr size_t WS_WINAB = 1 * MiB, WS_WOUTAB = 13 * MiB, WS_WINC = 17 * MiB, WS_WOUTC = 23 * MiB, WS_W13 = 27 * MiB, WS_W2 = 71 * MiB;
constexpr size_t WS_X = 93 * MiB, WS_H = 158 * MiB, WS_AO = 191 * MiB, WS_QK = 224 * MiB, WS_VT = 289 * MiB, WS_HID = 224 * MiB, WS_TMP = 322 * MiB, WS_END = 354 * MiB;

struct Args { const float* in[19]; float* out; unsigned char* ws; int ph_lo, ph_hi; };

DI unsigned pk_bf16(float a, float b) { f32v2 v = {a, b}; bf16v2 r = __builtin_convertvector(v, bf16v2); return __builtin_bit_cast(unsigned, r); }
#define dpp_f(v, ctrl) __builtin_bit_cast(float, __builtin_amdgcn_mov_dpp(__builtin_bit_cast(int, (v)), (ctrl), 0xF, 0xF, true))
DI int opaque_tid() { int t = threadIdx.x; asm volatile("" : "+v"(t)); return t; }
DI float xhalf_max(float v) {
    float a = v, b = v;
    asm volatile("s_nop 1\n\tv_permlane32_swap_b32 %0, %1" : "+v"(a), "+v"(b));
    return fmaxf(a, b); }
DI float fast_exp2(float x) { return __builtin_amdgcn_exp2f(x); }
DI float wave_sum(float v) {
    v += dpp_f(v, 0xB1);
    v += dpp_f(v, 0x4E);
    v += dpp_f(v, 0x124);
    v += dpp_f(v, 0x128);
    float a = v, b = v; asm volatile("s_nop 1\n\tv_permlane16_swap_b32 %0, %1" : "+v"(a), "+v"(b)); v = a + b;
    a = v; b = v; asm volatile("s_nop 1\n\tv_permlane32_swap_b32 %0, %1" : "+v"(a), "+v"(b)); return a + b; }

struct EpiQKV {
    static constexpr bool PERM = false, AFTER_DRAIN = false;
    bf16_t* QK; int ldqk; bf16_t* Vt; int nq, nrow; const f32v2* rope; unsigned rope_mask;
    DI void operator()(const f32x4 (&acc)[2][2][4][2], const pg8::Unit& u, int wr, int wc, int fr, int fq) const {
        if (u.pn < nrow) {
            const float sc = (u.pn < nq) ? QSCALE : 1.f;
            const bool do_rope = (u.pm < 64) && ((rope_mask >> u.pn) & 1u);
#pragma unroll
            for (int ai = 0; ai < 2; ++ai)
#pragma unroll
                for (int m = 0; m < 4; ++m) {
                    const int row = u.pm * 256 + ai * 128 + wr * 64 + m * 16 + fr;
                    f32x4 cc = {1.f, 1.f, 1.f, 1.f}, ss = {0.f, 0.f, 0.f, 0.f};
                    if (do_rope) {
                        const int pos = (wc & 1) ? (row & 63) : (row >> 6);
                        const f32x4* rp = (const f32x4*)(rope + pos * 16 + 4 * fq);
                        const f32x4 t0 = G1(rp)[0], t1 = G1(rp)[1];
                        cc = (f32x4){t0[0], t0[2], t1[0], t1[2]}; ss = (f32x4){t0[1], t0[3], t1[1], t1[3]};
                    }
#pragma unroll
                    for (int bj = 0; bj < 2; ++bj) {
                        const f32x4 x0 = acc[ai][bj][m][0], x1 = acc[ai][bj][m][1];
                        const f32x4 o0 = (x0 * cc - x1 * ss) * sc, o1 = (x1 * cc + x0 * ss) * sc;
                        bf16_t* p = QK + (size_t)row * ldqk + u.pn * 256 + bj * 128 + wc * 32 + 4 * fq;
                        u32x2 w0, w1; w0.x = pk_bf16(o0[0], o0[1]); w0.y = pk_bf16(o0[2], o0[3]); w1.x = pk_bf16(o1[0], o1[1]); w1.y = pk_bf16(o1[2], o1[3]);
                        *G1((u32x2*)p) = w0; *G1((u32x2*)(p + 16)) = w1;
                    }
                }
        } else {
            const int vr0 = (u.pn - nrow) * 256 + wc * 32 + 4 * fq;
#pragma unroll
            for (int ai = 0; ai < 2; ++ai)
#pragma unroll
                for (int m = 0; m < 4; ++m) {
                    const int row = u.pm * 256 + ai * 128 + wr * 64 + m * 16 + fr;
#pragma unroll
                    for (int bj = 0; bj < 2; ++bj)
#pragma unroll
                        for (int n = 0; n < 2; ++n) {
                            const f32x4 v = acc[ai][bj][m][n];
                            bf16_t* p = Vt + (size_t)(vr0 + bj * 128 + n * 16) * TP + row;
                            const unsigned a = pk_bf16(v[0], v[1]), b = pk_bf16(v[2], v[3]);
                            G1(p)[0] = (bf16_t)(a & 0xffffu); G1(p)[TP] = (bf16_t)(a >> 16); G1(p)[2 * (size_t)TP] = (bf16_t)(b & 0xffffu); G1(p)[3 * (size_t)TP] = (bf16_t)(b >> 16);
                        }
                }
        }
    }
};
struct EpiResid {
    static constexpr bool PERM = false, AFTER_DRAIN = false;
    float* X; const float* gate_x; const float* gate_c; const float* Xin;
    DI void operator()(const f32x4 (&acc)[2][2][4][2], const pg8::Unit& u, int wr, int wc, int fr, int fq) const {
        const float* gate = (u.pm < 64) ? gate_x : gate_c;
        const int col0 = u.pn * 256 + wc * 32 + 4 * fq;
#pragma unroll
        for (int ai = 0; ai < 2; ++ai)
#pragma unroll
            for (int m = 0; m < 4; ++m) {
                float* xr = X + (size_t)(u.pm * 256 + ai * 128 + wr * 64 + m * 16 + fr) * D + col0;
                const float* xi = Xin + (size_t)(u.pm * 256 + ai * 128 + wr * 64 + m * 16 + fr) * D + col0;
#pragma unroll
                for (int bj = 0; bj < 2; ++bj)
#pragma unroll
                    for (int n = 0; n < 2; ++n) { const f32x4 gv = *G1((const f32x4*)(gate + col0 + bj * 128 + n * 16)); *G1((f32x4*)(xr + bj * 128 + n * 16)) = *G1((const f32x4*)(xi + bj * 128 + n * 16)) + gv * acc[ai][bj][m][n]; }
                if (m & 1) asm volatile("" ::: "memory");
            }
    }
};
struct EpiPartial {
    static constexpr bool PERM = false, AFTER_DRAIN = false;
    float* part; const float* gate;
    DI void operator()(const f32x4 (&acc)[2][2][4][2], const pg8::Unit& u, int wr, int wc, int fr, int fq) const {
        const int col0 = u.pn * 256 + wc * 32 + 4 * fq;
        float* pb = part + (size_t)(u.ko >> 8) * (NCTX * D);
#pragma unroll
        for (int ai = 0; ai < 2; ++ai)
#pragma unroll
            for (int m = 0; m < 4; ++m) {
                float* xr = pb + (size_t)(ai * 128 + wr * 64 + m * 16 + fr) * D + col0;
#pragma unroll
                for (int bj = 0; bj < 2; ++bj)
#pragma unroll
                    for (int n = 0; n < 2; ++n) { const f32x4 gv = *G1((const f32x4*)(gate + col0 + bj * 128 + n * 16)); *G1((f32x4*)(xr + bj * 128 + n * 16)) = gv * acc[ai][bj][m][n]; }
                asm volatile("" ::: "memory");
            }
    }
};
struct CtxSplit {
    int nsplit, c;
    DI bool next(int i, pg8::Unit& u) const { if (i != 0 || c >= 4 * nsplit) return false; u.pm = 0; u.pn = c & 3; u.ko = (c >> 2) * 256; return true; }
    DI void a_ready(const pg8::Unit&) const {}
    DI void done(const pg8::Unit&) const {}
};
struct EpiSwiGLU {
    static constexpr bool PERM = false, AFTER_DRAIN = false;
    bf16_t* HID;
    DI void operator()(const f32x4 (&acc)[2][2][4][2], const pg8::Unit& u, int wr, int wc, int fr, int fq) const {
#pragma unroll
        for (int ai = 0; ai < 2; ++ai)
#pragma unroll
            for (int m = 0; m < 4; ++m) {
                bf16_t* hr = HID + (size_t)(u.pm * 256 + ai * 128 + wr * 64 + m * 16 + fr) * FFN + (u.pn * 256 + wc * 32) / 2 + 4 * fq;
#pragma unroll
                for (int bj = 0; bj < 2; ++bj) {
                    const f32x4 a = acc[ai][bj][m][0], b = acc[ai][bj][m][1]; f32x4 h;
#pragma unroll
                    for (int e = 0; e < 4; ++e) h[e] = a[e] * __builtin_amdgcn_rcpf(1.f + __expf(-a[e])) * b[e];
                    u32x2 w; w.x = pk_bf16(h[0], h[1]); w.y = pk_bf16(h[2], h[3]);
                    *G1((u32x2*)(hr + bj * 64)) = w;
                }
            }
    }
};

constexpr int AT_KB = 64 * 144, AT_VB = 128 * 144, AT_RPB = 2 * AT_KB + 2 * AT_VB;
static_assert(AT_RPB + 2048 <= LDS_BYTES, "attention LDS");

template <int DV, int MODE>
DI void attn_run(LAS unsigned char* lds, const bf16_t* QK, int ldqk, int qcol, int kcol, const bf16_t* Vt, int q0, int kt0, int kt1,
                 float minit, float linit, f32x16 (&o)[DV / 32], float& m_out, float& l_out) {
    const int tid = opaque_tid(), lane = tid & 63, wid = __builtin_amdgcn_readfirstlane(tid >> 6), r32 = lane & 31, hi = lane >> 5;
    const int qtok = q0 + 32 * wid + r32;
    bf16x8 qf[4];
#pragma unroll
    for (int kk = 0; kk < 4; ++kk) qf[kk] = *G1((const bf16x8*)(QK + (size_t)qtok * ldqk + qcol + 16 * kk + 8 * hi));
#pragma unroll
    for (int d = 0; d < DV / 32; ++d)
#pragma unroll
        for (int i = 0; i < 16; ++i) o[d][i] = 0.f;
    float m_ref = (linit != 0.f) ? minit : 0.f, m_run = (linit != 0.f) ? 0.f : NEGBIG, l = (hi == 0) ? linit : 0.f;
    f32x16 negm;
#pragma unroll
    for (int i = 0; i < 16; ++i) negm[i] = -m_ref;
    asm volatile("" : "+v"(negm));
    const int ntiles = 4 + (kt1 - kt0);
    const int srow = tid >> 3, sch = tid & 7;
    const int qr = (q0 >> 6) + (wid >> 1), qc = 32 * (wid & 1) + r32;
    u32x4 kreg, vreg[DV / 64];
#define AT_TOK(j) ((j) < 4 ? SEQ + 64 * (j) : 64 * (kt0 + (j) - 4))
#define AT_LOAD(j) do { const int tk_ = AT_TOK(j); kreg = *G1((const u32x4*)(QK + (size_t)(tk_ + srow) * ldqk + kcol + sch * 8)); \
        _Pragma("unroll") for (int v_ = 0; v_ < DV / 64; ++v_) vreg[v_] = *G1((const u32x4*)(Vt + (size_t)(srow + 64 * v_) * TP + tk_ + sch * 8)); } while (0)
#define AT_STORE(b) do { *(LAS u32x4*)(lds + (b) * AT_KB + srow * 144 + sch * 16) = kreg; \
        _Pragma("unroll") for (int v_ = 0; v_ < DV / 64; ++v_) { LAS unsigned char* p_ = lds + 2 * AT_KB + (b) * AT_VB + (srow + 64 * v_) * 144 + (sch >> 1) * 32 + (sch & 1) * 8; \
            *(LAS u32x2*)p_ = (u32x2){vreg[v_].x, vreg[v_].y}; *(LAS u32x2*)(p_ + 16) = (u32x2){vreg[v_].z, vreg[v_].w}; } } while (0)
    AT_LOAD(0);
    AT_STORE(0);
    __syncthreads();
    for (int j = 0; j < ntiles; ++j) {
        const int b = j & 1;
        if (j + 1 < ntiles) AT_LOAD(j + 1);
        const int tok0 = AT_TOK(j); const bool lat = j >= 4;
        bool active = true;
        if (MODE == 1 && lat) { const int kr = tok0 >> 6; const int rs = min(max(qr - 4, 0), 248); active = (kr >= rs) && (kr <= rs + 7); }
        if (MODE == 2 && lat) { const int wq0 = q0 + 32 * wid; active = (tok0 + 63 >= wq0 - 128) && (tok0 <= wq0 + 31 + 128); }
        if (active) {
            const LAS unsigned char* Kb = lds + b * AT_KB; const LAS unsigned char* Vb = lds + 2 * AT_KB + b * AT_VB;
            f32x16 st[2];
            {
                bf16x8 kf[2][4];
#pragma unroll
                for (int kb = 0; kb < 2; ++kb)
#pragma unroll
                    for (int kk = 0; kk < 4; ++kk) kf[kb][kk] = *(const LAS bf16x8*)(Kb + (32 * kb + r32) * 144 + (16 * kk + 8 * hi) * 2);
#pragma unroll
                for (int kk = 0; kk < 4; ++kk)
#pragma unroll
                    for (int kb = 0; kb < 2; ++kb) st[kb] = MFMA32(kf[kb][kk], qf[kk], kk == 0 ? negm : st[kb]);
            }
            bf16x8 vf[3][DV / 32];
#define AT_VLOAD(g, dst) do { _Pragma("unroll") for (int d = 0; d < DV / 32; ++d) { dst[d] = *(const LAS bf16x8*)(Vb + (32 * d + r32) * 144 + (g) * 32 + hi * 16); } } while (0)
            AT_VLOAD(0, vf[0]); AT_VLOAD(1, vf[1]);
            if (MODE == 1 && lat) {
                const LAS float* rpbL = (const LAS float*)(lds + AT_RPB);
                const int kr = tok0 >> 6, cs = min(max(qc - 8, 0), 48), rb = (kr - qr + 7) * 32 - qc + 15 + 4 * hi;
#pragma unroll
                for (int kb = 0; kb < 2; ++kb)
#pragma unroll
                    for (int i = 0; i < 16; ++i) { const int kcc = 32 * kb + (i & 3) + 8 * (i >> 2); const bool valid = (unsigned)(kcc + 4 * hi - cs) < 16u;
                        const float bias = rpbL[valid ? rb + kcc : 0]; st[kb][i] = valid ? st[kb][i] + bias : NEGBIG; }
            }
            if (MODE == 2 && lat) {
#pragma unroll
                for (int kb = 0; kb < 2; ++kb)
#pragma unroll
                    for (int i = 0; i < 16; ++i) { const int kpos = tok0 + 32 * kb + (i & 3) + 8 * (i >> 2) + 4 * hi; const bool valid = (unsigned)(kpos - qtok + 128) <= 256u;
                        st[kb][i] = valid ? st[kb][i] : NEGBIG; }
            }
            float mxp[4];
#pragma unroll
            for (int c = 0; c < 4; ++c) { mxp[c] = fmaxf(st[0][4 * c], st[1][4 * c]);
#pragma unroll
                for (int i = 1; i < 4; ++i) mxp[c] = fmaxf(fmaxf(mxp[c], st[0][4 * c + i]), st[1][4 * c + i]); }
            float mx = fmaxf(fmaxf(mxp[0], mxp[1]), fmaxf(mxp[2], mxp[3]));
            mx = xhalf_max(mx);
            m_run = fmaxf(m_run, mx);
            if (__builtin_amdgcn_ballot_w64(m_run > 8.f || m_run < -24.f) != 0ull) {
                const float delta = (m_run > -1e29f) ? m_run : 0.f, alpha = fast_exp2(-delta);
                m_ref += delta; m_run -= delta; l *= alpha;
#pragma unroll
                for (int d = 0; d < DV / 32; ++d) o[d] = o[d] * alpha;
#pragma unroll
                for (int kb = 0; kb < 2; ++kb)
#pragma unroll
                    for (int i = 0; i < 16; ++i) st[kb][i] -= delta;
#pragma unroll
                for (int i = 0; i < 16; ++i) negm[i] = -m_ref;
                asm volatile("" : "+v"(negm));
            }
            float rs4[4] = {0.f, 0.f, 0.f, 0.f};
#pragma unroll
            for (int kb = 0; kb < 2; ++kb)
#pragma unroll
                for (int i = 0; i < 16; ++i) { const float p = fast_exp2(st[kb][i]); st[kb][i] = p; rs4[i & 3] += p; }
            l += (rs4[0] + rs4[1]) + (rs4[2] + rs4[3]);
            {
#pragma unroll
                for (int g = 0; g < 4; ++g) {
                    if (g + 2 < 4) AT_VLOAD(g + 2, vf[(g + 2) % 3]);
                    const int kb = g >> 1, s = g & 1;
                    u32x4 pp;
                    pp.x = pk_bf16(st[kb][8 * s + 0], st[kb][8 * s + 1]); pp.y = pk_bf16(st[kb][8 * s + 2], st[kb][8 * s + 3]);
                    pp.z = pk_bf16(st[kb][8 * s + 4], st[kb][8 * s + 5]); pp.w = pk_bf16(st[kb][8 * s + 6], st[kb][8 * s + 7]);
                    const bf16x8 pf = __builtin_bit_cast(bf16x8, pp);
#pragma unroll
                    for (int d = 0; d < DV / 32; ++d) o[d] = MFMA32(vf[g % 3][d], pf, o[d]);
                }
#undef AT_VLOAD
            }
        }
        if (j + 1 < ntiles) AT_STORE(b ^ 1);
        __syncthreads();
    }
#undef AT_TOK
#undef AT_LOAD
#undef AT_STORE
    m_out = m_ref; l_out = l + __shfl_xor(l, 32);
}

template <int NB>
DI void store_rows(bf16_t* dst  , const f32x16 (&o)[NB], float sc, const float* gain, int hi) {
#pragma unroll
    for (int d = 0; d < NB; ++d)
#pragma unroll
        for (int g = 0; g < 4; ++g) {
            const int c = 32 * d + 8 * g + 4 * hi;
            f32x4 gg = {1.f, 1.f, 1.f, 1.f}; if (gain) gg = *G1((const f32x4*)(gain + c));
            u32x2 w; w.x = pk_bf16(o[d][4 * g] * sc * gg[0], o[d][4 * g + 1] * sc * gg[1]); w.y = pk_bf16(o[d][4 * g + 2] * sc * gg[2], o[d][4 * g + 3] * sc * gg[3]);
            *G1((u32x2*)(dst + c)) = w;
            if (g == 3) asm volatile("" ::: "memory");
        }
}

#define AT_DEQ_ISSUE() unsigned nxt_ = 0u; if (threadIdx.x == 0) nxt_ = __hip_atomic_fetch_add(qctr, 1u, __ATOMIC_RELAXED, __HIP_MEMORY_SCOPE_AGENT)
#define AT_DEQ_TAKE() do { volatile LAS unsigned* qw_ = (volatile LAS unsigned*)(lds + LDS_MISC + 64); if (threadIdx.x == 0) *qw_ = nxt_ + gridDim.x; __syncthreads(); \
        u = __builtin_amdgcn_readfirstlane((int)*qw_); __syncthreads(); } while (0)
DI void attn_even_phase(LAS unsigned char* lds, const float* in_subg, const float* in_rpb, unsigned char* ws, int e, unsigned* qctr) {
    const bf16_t* QK = (const bf16_t*)(ws + WS_QK); const bf16_t* Vt = (const bf16_t*)(ws + WS_VT); bf16_t* AO = (bf16_t*)(ws + WS_AO);
    float* tmp = (float*)(ws + WS_TMP) + (size_t)blockIdx.x * (64 * NTHR);
    const int tid = opaque_tid(), lane = tid & 63, wid = tid >> 6, r32 = lane & 31, hi = lane >> 5;
    const float lam = ((const float*)(ws + WS_LAM))[e];
    const float one_m = 1.f - (e == 0 ? 0.2f : 0.47071301834358416f);
    const float* sub_g = in_subg + e * 128;
    const int NU = 260 + 520;
    int u = blockIdx.x;
    while (u < NU) {
        AT_DEQ_ISSUE();
        if (u < 256 || (u >= 768 && u < 772)) {
            int qt, h;
            if (u < 256) { h = (u & 7) >> 1; qt = 2 * (u >> 3) + (u & 1); } else { qt = 64; h = u - 768; }
            const int q0 = 256 * qt, kt1 = qt < 64 ? 256 : 0, qtok = q0 + 32 * wid + r32;
            f32x16 o[4]; float m, l;
            attn_run<128, 0>(lds, QK, 2048, (2 * h) * 64, 1024 + (2 * h) * 64, Vt + (size_t)(h * 128) * TP, q0, 0, kt1, NEGBIG, 0.f, o, m, l);
            { const float inv = 1.f / l;
#pragma unroll
              for (int d = 0; d < 4; ++d)
#pragma unroll
                  for (int g = 0; g < 4; ++g) *G1((f32x4*)(tmp + tid * 64 + d * 16 + 4 * g)) = (f32x4){o[d][4 * g], o[d][4 * g + 1], o[d][4 * g + 2], o[d][4 * g + 3]} * inv; }
            attn_run<128, 0>(lds, QK, 2048, (2 * h + 1) * 64, 1024 + (2 * h + 1) * 64, Vt + (size_t)(h * 128) * TP, q0, 0, kt1, NEGBIG, 0.f, o, m, l);
            const float inv2 = lam / l; float ss = 0.f;
#pragma unroll
            for (int d = 0; d < 4; ++d) {
#pragma unroll
                for (int g = 0; g < 4; ++g) { const f32x4 t4 = *G1((const f32x4*)(tmp + tid * 64 + d * 16 + 4 * g));
#pragma unroll
                    for (int e = 0; e < 4; ++e) { const float v = t4[e] - o[d][4 * g + e] * inv2; o[d][4 * g + e] = v; ss += v * v; } }
                asm volatile("" ::: "memory");
            }
            ss += __shfl_xor(ss, 32);
            const float rstd = rsqrtf(ss * (1.f / 128.f) + NORM_EPS) * one_m;
            store_rows<4>(AO + (size_t)qtok * D + h * 128, o, rstd, sub_g, hi);
        } else {
            const int v = (u < 768) ? u - 256 : 512 + (u - 772), qt = v >> 3, head = v & 7;
            const int q0 = 256 * qt, qtok = q0 + 32 * wid + r32;
            int kt0 = 0, kt1 = 0;
            if (qt < 64) { const int r0 = 4 * qt; kt0 = min(max(r0 - 4, 0), 248); kt1 = min(max(r0 - 1, 0), 248) + 8; }
            { LAS float* rpbL = (LAS float*)(lds + AT_RPB); const float* rp = in_rpb + ((size_t)e * 8 + head) * (15 * 31);
              if (tid < 480) { const int r = tid >> 5, c = tid & 31; rpbL[tid] = (c < 31) ? G1(rp)[r * 31 + c] * LOG2E : 0.f; } }
            f32x16 o[2]; float m, l;
            attn_run<64, 1>(lds, QK, 2048, 512 + head * 64, 1536 + head * 64, Vt + (size_t)(512 + head * 64) * TP, q0, kt0, kt1, NEGBIG, 0.f, o, m, l);
            store_rows<2>(AO + (size_t)qtok * D + 512 + head * 64, o, 1.f / l, nullptr, hi);
        }
        AT_DEQ_TAKE();
    }
}
DI void attn_odd_phase(LAS unsigned char* lds, const float* in_sinks, unsigned char* ws, int od, unsigned* qctr) {
    const bf16_t* QK = (const bf16_t*)(ws + WS_QK); const bf16_t* Vt = (const bf16_t*)(ws + WS_VT); bf16_t* AO = (bf16_t*)(ws + WS_AO);
    const int tid = opaque_tid(), lane = tid & 63, wid = tid >> 6, r32 = lane & 31, hi = lane >> 5;
    const int NU = 65 * 16;
    int u = blockIdx.x;
    while (u < NU) {
        AT_DEQ_ISSUE();
        int qt = u >> 4, head = u & 15;
        if (u < 256 && gridDim.x == 256) {
            const int xcd = u & 7, i = u >> 3; head = 4 * (xcd & 3) + (i & 3); qt = 2 * (i >> 2) + (xcd >> 2); }
        const int kvh = head >> 2;
        const int q0 = 256 * qt, qtok = q0 + 32 * wid + r32;
        int kt0 = 0, kt1 = 0;
        if (qt < 64) { kt0 = max(4 * qt - 2, 0); kt1 = min(4 * qt + 6, 256); }
        const float sink = G1(in_sinks)[od * 16 + head] * LOG2E;
        f32x16 o[2]; float m, l;
        attn_run<64, 2>(lds, QK, 1280, head * 64, 1024 + kvh * 64, Vt + (size_t)(kvh * 64) * TP, q0, kt0, kt1, sink, 1.f, o, m, l);
        store_rows<2>(AO + (size_t)qtok * D + head * 64, o, 1.f / l, nullptr, hi);
        AT_DEQ_TAKE();
    }
}

DI void xpose_item(const float* W, int K, int N, bf16_t* WT, int mode, LAS float* scr, int item, int lane) {
    const int nblk = N / 32, kb = item / nblk, nb = item % nblk, k0 = 64 * kb, n0 = 32 * nb;
    float wv[32];
#pragma unroll
    for (int i = 0; i < 32; ++i) wv[i] = G1(W)[(size_t)(k0 + 2 * i + (lane >> 5)) * N + n0 + (lane & 31)];
#pragma unroll
    for (int i = 0; i < 32; ++i) scr[(2 * i + (lane >> 5)) * 33 + (lane & 31)] = wv[i];
    asm volatile("s_waitcnt lgkmcnt(0)" ::: "memory");
    const int c = lane & 7;
#pragma unroll
    for (int j = 0; j < 4; ++j) {
        const int nl = (lane >> 3) + 8 * j, n = n0 + nl; const LAS float* s = scr + (8 * c) * 33 + nl;
        int nd = n;
        if (mode == 1) { const int seg = n >> 9; nd = ((seg == 3) ? 4 : (seg == 4) ? 3 : seg) * 512 + (n & 511); }
        else if (mode == 2) nd = (n >> 4) * 32 + (n & 15);
        else if (mode == 3) nd = (n >> 4) * 32 + 16 + (n & 15);
        u32x4 o; o.x = pk_bf16(s[0 * 33], s[1 * 33]); o.y = pk_bf16(s[2 * 33], s[3 * 33]); o.z = pk_bf16(s[4 * 33], s[5 * 33]); o.w = pk_bf16(s[6 * 33], s[7 * 33]);
        *G1((u32x4*)(WT + (size_t)nd * K + k0 + 8 * c)) = o;
    }
    asm volatile("s_waitcnt lgkmcnt(0)" ::: "memory");
}

DI void prologue(LAS unsigned char* lds, const Args& a) {
    unsigned char* ws = a.ws;
    const int tid = opaque_tid(), lane = tid & 63, wave = tid >> 6, G = gridDim.x, gw = blockIdx.x * NWAVES + wave, NGW = G * NWAVES;
    float* mod = (float*)(ws + WS_MOD);
    __syncthreads();
    for (int bi = blockIdx.x; bi < 96; bi += G) {
        const int l = bi / 24, ch = bi % 24;
        LAS float* sv = (LAS float*)lds; LAS float* red = (LAS float*)(lds + 8192);
        for (int i = tid; i < 2048; i += NTHR) { const float v = (i < 1024) ? a.in[1][i] : a.in[3][i - 1024]; sv[i] = v / (1.f + expf(-v)); }
        __syncthreads();
        const float* W = a.in[4] + (size_t)l * 1024 * 6144 + ch * 256 + lane * 4;
        f32x4 ax = {0.f, 0.f, 0.f, 0.f}, ac = {0.f, 0.f, 0.f, 0.f};
        const int k0 = wave * 128;
#pragma unroll 8
        for (int k = 0; k < 128; ++k) { const f32x4 w = *G1((const f32x4*)(W + (size_t)(k0 + k) * 6144)); ax += w * sv[k0 + k]; ac += w * sv[1024 + k0 + k]; }
        *(LAS f32x4*)(red + (wave * 2 + 0) * 256 + lane * 4) = ax;
        *(LAS f32x4*)(red + (wave * 2 + 1) * 256 + lane * 4) = ac;
        __syncthreads();
        { const int g = tid >> 8, col = tid & 255; float s = a.in[5][l * 6144 + ch * 256 + col];
          for (int w = 0; w < 8; ++w) s += red[(w * 2 + g) * 256 + col];
          mod[(l * 2 + g) * 6144 + ch * 256 + col] = s; }
        __syncthreads();
    }
    for (int i = blockIdx.x * NTHR + tid; i < 4096; i += G * NTHR) {
        const int pos = i >> 4, fi = i & 15; const float inv = powf(10000.f, -(float)fi / 16.f), ang = (float)pos * inv;
        ((f32v2*)(ws + WS_ROPE))[i] = (f32v2){cosf(ang), sinf(ang)};
    }
    if (blockIdx.x == 0 && tid < 2) {
        const float* L = a.in[9] + tid * 256; float s1 = 0.f, s2 = 0.f;
        for (int i = 0; i < 64; ++i) { s1 += L[i] * L[64 + i]; s2 += L[128 + i] * L[192 + i]; }
        ((float*)(ws + WS_LAM))[tid] = expf(s1) - expf(s2) + (tid == 0 ? 0.2f : 0.47071301834358416f);
    }
    LAS float* scr = (LAS float*)(lds + wave * 8448);
    bf16_t* WinAB = (bf16_t*)(ws + WS_WINAB); bf16_t* WoutAB = (bf16_t*)(ws + WS_WOUTAB); bf16_t* WinC = (bf16_t*)(ws + WS_WINC); bf16_t* WoutC = (bf16_t*)(ws + WS_WOUTC);
    bf16_t* W13 = (bf16_t*)(ws + WS_W13); bf16_t* W2 = (bf16_t*)(ws + WS_W2);
    constexpr int NTOT = 3072 + 1024 + 1536 + 1024 + 5632 + 5632 + 5632;
    for (int it = gw; it < NTOT; it += NGW) {
        int r = it;
        if (r < 3072) { const int e = r / 1536; xpose_item(a.in[7] + (size_t)e * 1024 * 3072, 1024, 3072, WinAB + (size_t)e * 3072 * 1024, 1, scr, r % 1536, lane); continue; } r -= 3072;
        if (r < 1024) { const int e = r / 512; xpose_item(a.in[8] + (size_t)e * 1024 * 1024, 1024, 1024, WoutAB + (size_t)e * 1024 * 1024, 0, scr, r % 512, lane); continue; } r -= 1024;
        if (r < 1536) { const int e = r / 768; xpose_item(a.in[12] + (size_t)e * 1024 * 1536, 1024, 1536, WinC + (size_t)e * 1536 * 1024, 0, scr, r % 768, lane); continue; } r -= 1536;
        if (r < 1024) { const int e = r / 512; xpose_item(a.in[13] + (size_t)e * 1024 * 1024, 1024, 1024, WoutC + (size_t)e * 1024 * 1024, 0, scr, r % 512, lane); continue; } r -= 1024;
        if (r < 5632) { const int l = r / 1408; xpose_item(a.in[15] + (size_t)l * 1024 * FFN, 1024, FFN, W13 + (size_t)l * FFN2 * 1024, 2, scr, r % 1408, lane); continue; } r -= 5632;
        if (r < 5632) { const int l = r / 1408; xpose_item(a.in[16] + (size_t)l * 1024 * FFN, 1024, FFN, W13 + (size_t)l * FFN2 * 1024, 3, scr, r % 1408, lane); continue; } r -= 5632;
        { const int l = r / 1408; xpose_item(a.in[17] + (size_t)l * FFN * 1024, FFN, 1024, W2 + (size_t)l * 1024 * FFN, 0, scr, r % 1408, lane); }
    }
}

DI void norm_phase(unsigned char* ws, const float* src_x, const float* src_c  , const float* g, const float* modl  , int shift_i, int npart  ) {
    bf16_t* H = (bf16_t*)(ws + WS_H);
    const int tid = opaque_tid(), lane = tid & 63, wave = tid >> 6, gw = blockIdx.x * NWAVES + wave, NGW = gridDim.x * NWAVES;
    for (int r = gw; r < T; r += NGW) {
        const float* xr = (r < SEQ ? src_x + (size_t)r * D : src_c + (size_t)(r - SEQ) * D) + 4 * lane; const float* md = modl + (r >= SEQ ? 6144 : 0) + shift_i * 1024 + 4 * lane;
        f32x4 v[4]; float ss = 0.f;
#pragma unroll
        for (int j = 0; j < 4; ++j) v[j] = *G1((const f32x4*)(xr + 256 * j));
        if (r >= SEQ && npart > 0) {
            const float* pr = (const float*)(ws + WS_TMP) + (size_t)(r - SEQ) * D + 4 * lane;
            for (int s = 0; s < npart; ++s)
#pragma unroll
                for (int j = 0; j < 4; ++j) v[j] += *G1((const f32x4*)(pr + (size_t)s * (NCTX * D) + 256 * j));
#pragma unroll
            for (int j = 0; j < 4; ++j) *G1((f32x4*)((float*)(ws + WS_X) + (size_t)r * D + 4 * lane + 256 * j)) = v[j];
        }
#pragma unroll
        for (int j = 0; j < 4; ++j) ss += (v[j].x * v[j].x + v[j].y * v[j].y) + (v[j].z * v[j].z + v[j].w * v[j].w);
        const float rstd = rsqrtf(wave_sum(ss) * (1.f / D) + NORM_EPS);
#pragma unroll
        for (int j = 0; j < 4; ++j) {
            const f32x4 gg = *G1((const f32x4*)(g + 4 * lane + 256 * j)), sh = *G1((const f32x4*)(md + 256 * j)), sc = *G1((const f32x4*)(md + 1024 + 256 * j));
            const f32x4 y = (v[j] * rstd * gg) * (sc + 1.f) + sh;
            u32x2 w; w.x = pk_bf16(y[0], y[1]); w.y = pk_bf16(y[2], y[3]);
            *G1((u32x2*)(H + (size_t)r * D + 4 * lane + 256 * j)) = w;
        }
    }
}
DI void final_norm(const Args& a) {
    const float* X = (const float*)(a.ws + WS_X); const float* g = a.in[18];
    const int tid = opaque_tid(), lane = tid & 63, wave = tid >> 6, gw = blockIdx.x * NWAVES + wave, NGW = gridDim.x * NWAVES;
    for (int r = gw; r < SEQ; r += NGW) {
        const float* xr = X + (size_t)r * D + 4 * lane;
        f32x4 v[4]; float ss = 0.f;
#pragma unroll
        for (int j = 0; j < 4; ++j) { v[j] = *G1((const f32x4*)(xr + 256 * j)); ss += (v[j].x * v[j].x + v[j].y * v[j].y) + (v[j].z * v[j].z + v[j].w * v[j].w); }
        const float rstd = rsqrtf(wave_sum(ss) * (1.f / D) + NORM_EPS);
#pragma unroll
        for (int j = 0; j < 4; ++j) { const f32x4 gg = *G1((const f32x4*)(g + 4 * lane + 256 * j)); *G1((f32x4*)(a.out + (size_t)r * D + 4 * lane + 256 * j)) = v[j] * rstd * gg; }
    }
}

#define XB_TMO      128
#define XB_XCNT(j)  (256  + 64 * (j))
#define XB_XSUB(j)  (1280 + 64 * (j))
#define XB_XGEN(j)  (2304 + 64 * (j))
#define XB_TOP      3328
#define XB_TOPGEN   3392
#define XCD_BAR_WORDS 3456
#define XB_SPIN_CAP (1u << 18)

__device__ __forceinline__ unsigned xb_ld(unsigned* p)              { return __hip_atomic_load(p, __ATOMIC_RELAXED, __HIP_MEMORY_SCOPE_AGENT); }
__device__ __forceinline__ unsigned xb_add(unsigned* p, unsigned v) { return __hip_atomic_fetch_add(p, v, __ATOMIC_RELAXED, __HIP_MEMORY_SCOPE_AGENT); }
__device__ __forceinline__ unsigned xb_xcc_id() { return (unsigned)__builtin_amdgcn_s_getreg((3 << 11) | 20) & 0xFu; }
#define XB_SPIN(cond, bar) do { unsigned _sp = 0; while (cond) { __builtin_amdgcn_s_sleep(1); \
    if ((++_sp & 255u) == 0u) { if (xb_ld(&(bar)[XB_TMO])) break; if (_sp > XB_SPIN_CAP) { atomicAdd(&(bar)[XB_TMO], 1u); break; } } } } while (0)

struct XcdBarrier {
    unsigned* bar; unsigned x;
    volatile LAS unsigned* st;
};

__device__ __forceinline__ XcdBarrier xcd_barrier_post(unsigned* bar, volatile LAS unsigned* st) {
    XcdBarrier b; b.bar = bar; b.x = xb_xcc_id(); b.st = st;
    if (threadIdx.x == 0) (void)xb_add(&bar[XB_XCNT(b.x)], 1u);
    return b;
}
__device__ __forceinline__ void xcd_barrier_complete(unsigned* bar, unsigned x, unsigned& nloc, unsigned& nx) {
    const unsigned G = gridDim.x * gridDim.y * gridDim.z;
    unsigned sum, cnt, mine, sp = 0u;
    for (;;) {
        sum = 0u; cnt = 0u; mine = 0u;
#pragma unroll
        for (unsigned j = 0; j < 16; ++j) { const unsigned c = xb_ld(&bar[XB_XCNT(j)]); sum += c; cnt += (c > 0u) ? 1u : 0u; mine = (j == x) ? c : mine; }
        if (sum == G) break;
        __builtin_amdgcn_s_sleep(1);
        if ((++sp & 255u) == 0u) { if (xb_ld(&bar[XB_TMO])) break; if (sp > XB_SPIN_CAP) { atomicAdd(&bar[XB_TMO], 1u); break; } }
    }
    nloc = mine > 0u ? mine : 1u; nx = cnt > 0u ? cnt : 1u;
}

__device__ __forceinline__ void xcd_barrier(const XcdBarrier& b) {
    asm volatile("s_waitcnt vmcnt(0)" ::: "memory");
    __syncthreads();
    if (threadIdx.x == 0) {
        unsigned* bar = b.bar;
        __builtin_amdgcn_s_waitcnt(0);
        unsigned nloc = b.st[0], nx = b.st[1];
        if (nloc == 0u) { xcd_barrier_complete(bar, b.x, nloc, nx); b.st[0] = nloc; b.st[1] = nx; }
        const unsigned old = xb_add(&bar[XB_XSUB(b.x)], 1u);
        const unsigned gen = old / nloc;
        if (old + 1u == (gen + 1u) * nloc) {
            __builtin_amdgcn_fence(__ATOMIC_RELEASE, "agent");
            asm volatile("s_waitcnt vmcnt(0)" ::: "memory");
            const unsigned og = xb_add(&bar[XB_TOP], 1u);
            const unsigned tg = og / nx;
            if (og + 1u == (tg + 1u) * nx) xb_add(&bar[XB_TOPGEN], 1u);
            else XB_SPIN(xb_ld(&bar[XB_TOPGEN]) == tg, bar);
            __builtin_amdgcn_fence(__ATOMIC_ACQUIRE, "agent");
            xb_add(&bar[XB_XGEN(b.x)], 1u);
            asm volatile("s_waitcnt vmcnt(0)" ::: "memory");
        } else {
            XB_SPIN(xb_ld(&bar[XB_XGEN(b.x)]) == gen, bar);
            __builtin_amdgcn_fence(__ATOMIC_ACQUIRE, "agent");
            asm volatile("s_waitcnt vmcnt(0)" ::: "memory");
        }
    }
    __syncthreads();
}

#ifndef MK_SPLIT
#define MK_SPLIT 0
#endif
constexpr int N_PHASES = 2 + 7 * DEPTH;
#ifndef REP_ATT
#define REP_ATT 1
#endif
#ifndef REP_G2
#define REP_G2 1
#endif
#ifndef REP_G4
#define REP_G4 1
#endif
#ifndef REP_G
#define REP_G 1
#endif
#ifndef REP_NORM
#define REP_NORM 1
#endif
#ifndef REP_SYNC
#define REP_SYNC 1
#endif
#ifndef REP_PRO
#define REP_PRO 1
#endif

__global__ void __launch_bounds__(NTHR) mega_fwd(Args a) {
    extern __shared__ __attribute__((aligned(16))) unsigned char lds_raw[];
    LAS unsigned char* lds = (LAS unsigned char*)lds_raw;
    cg::grid_group grid = cg::this_grid();
    { volatile LAS unsigned* misc = (volatile LAS unsigned*)(lds + LDS_MISC); if (threadIdx.x < 16) misc[threadIdx.x] = 0u; }
    __syncthreads();
    XcdBarrier bar = xcd_barrier_post((unsigned*)(a.ws + WS_BAR), (volatile LAS unsigned*)(lds + LDS_MISC));
    const int lo = a.ph_lo, hi = a.ph_hi;
    int ph = 0;
#define PH_BEGIN if (ph >= lo && ph < hi) {
#define PH_END   if (ph + 1 < hi) { for (int rs_ = 0; rs_ < REP_SYNC; ++rs_) { if (lo < 0) grid.sync(); else xcd_barrier(bar); }     } } ++ph;
    PH_BEGIN for (int rp_ = 0; rp_ < REP_PRO; ++rp_) prologue(lds, a); PH_END

    for (int l = 0; l < DEPTH; ++l) {
        unsigned char* ws = a.ws; asm volatile("" : "+s"(ws));
        const float* in6 = a.in[6]; const float* in10 = a.in[10]; const float* in11 = a.in[11]; const float* in14 = a.in[14];
        asm volatile("" : "+s"(in6), "+s"(in10), "+s"(in11), "+s"(in14));
        const float* mod = (const float*)(ws + WS_MOD);
        bf16_t* H = (bf16_t*)(ws + WS_H); bf16_t* AO = (bf16_t*)(ws + WS_AO); bf16_t* QK = (bf16_t*)(ws + WS_QK); bf16_t* Vt = (bf16_t*)(ws + WS_VT); bf16_t* HID = (bf16_t*)(ws + WS_HID);
        float* X = (float*)(ws + WS_X);
        const int odd = l & 1, idx = l >> 1;
        const int Mr = (l == DEPTH - 1) ? SEQ : T;
        const float* modl = mod + (size_t)l * 2 * 6144;
        PH_BEGIN for (int rn_ = 0; rn_ < REP_NORM; ++rn_) norm_phase(ws, l == 0 ? a.in[0] : (const float*)X, l == 0 ? a.in[2] : (const float*)X + (size_t)SEQ * D, in6 + (l * 2 + 0) * D, modl, 0, l > 0 ? 11 : 0); PH_END
        PH_BEGIN {
            const bf16_t* W = odd ? (const bf16_t*)(ws + WS_WINC) + (size_t)idx * 1536 * 1024 : (const bf16_t*)(ws + WS_WINAB) + (size_t)idx * 3072 * 1024;
            const int N = odd ? 1536 : 3072;
            pg8::Gemm g{H, W, T, N, D, D}; pg8::StaticOrder S; S.init(T, N, gridDim.x, (int)blockIdx.x);
            EpiQKV E{QK, odd ? 1280 : 2048, Vt, 4, odd ? 5 : 8, (const f32v2*)(ws + WS_ROPE), odd ? 0x1fu : 0x33u};
            for (int rg_ = 0; rg_ < REP_G; ++rg_) pg8::gemm_phase<EpiQKV, pg8::StaticOrder, true, true>(lds, g, S, E);
        } PH_END
        PH_BEGIN
        for (int rep = 0; rep < REP_ATT; ++rep) { unsigned* qctr = (unsigned*)(ws + WS_BAR + 24576) + (l * REP_ATT + rep) * 64; if (odd) attn_odd_phase(lds, in14, ws, idx, qctr); else attn_even_phase(lds, in10, in11, ws, idx, qctr); }
        PH_END
        PH_BEGIN {
            const bf16_t* W = odd ? (const bf16_t*)(ws + WS_WOUTC) + (size_t)idx * 1024 * 1024 : (const bf16_t*)(ws + WS_WOUTAB) + (size_t)idx * 1024 * 1024;
            pg8::Gemm g{AO, W, SEQ, D, D, D}; pg8::StaticOrder S; S.init(SEQ, D, gridDim.x, (int)blockIdx.x);
            EpiResid E{X, modl + 2 * 1024, modl + 6144 + 2 * 1024, l == 0 ? a.in[0] : (const float*)X};
            pg8::gemm_phase<EpiResid, pg8::StaticOrder, true, true>(lds, g, S, E);
            if (l < DEPTH - 1) {
                pg8::Gemm gc{AO + (size_t)SEQ * D, W, NCTX, D, 256, D}; CtxSplit Sc{4, (int)blockIdx.x};
                EpiPartial Ec{(float*)(ws + WS_TMP), modl + 6144 + 2 * 1024};
                pg8::gemm_phase<EpiPartial, CtxSplit, true, true>(lds, gc, Sc, Ec);
            }
#if REP_G2 > 1
            { EpiResid Ez{X, (const float*)(ws + WS_ZERO), (const float*)(ws + WS_ZERO), (const float*)X}; pg8::gemm_phase<EpiResid, pg8::StaticOrder, true, true>(lds, g, S, Ez); }
#endif
        } PH_END
        PH_BEGIN for (int rn_ = 0; rn_ < REP_NORM; ++rn_) norm_phase(ws, (const float*)X, l == 0 ? a.in[2] : (const float*)X + (size_t)SEQ * D, in6 + (l * 2 + 1) * D, modl, 3, l < DEPTH - 1 ? 4 : 0); PH_END
        PH_BEGIN {
            pg8::Gemm g{H, (const bf16_t*)(ws + WS_W13) + (size_t)l * FFN2 * 1024, Mr, FFN2, D, D}; pg8::StaticOrder S; S.init(Mr, FFN2, gridDim.x, (int)blockIdx.x);
            EpiSwiGLU E{HID};
            for (int rg_ = 0; rg_ < REP_G; ++rg_) pg8::gemm_phase<EpiSwiGLU, pg8::StaticOrder, true, true>(lds, g, S, E);
        } PH_END
        PH_BEGIN {
            pg8::Gemm g{HID, (const bf16_t*)(ws + WS_W2) + (size_t)l * 1024 * FFN, SEQ, D, FFN, FFN}; pg8::StaticOrder S; S.init(SEQ, D, gridDim.x, (int)blockIdx.x);
            EpiResid E{X, modl + 5 * 1024, modl + 6144 + 5 * 1024, (const float*)X};
            pg8::gemm_phase<EpiResid, pg8::StaticOrder, true, true>(lds, g, S, E);
            if (l < DEPTH - 1) {
                pg8::Gemm gc{HID + (size_t)SEQ * FFN, (const bf16_t*)(ws + WS_W2) + (size_t)l * 1024 * FFN, NCTX, D, 256, FFN}; CtxSplit Sc{11, (int)blockIdx.x};
                EpiPartial Ec{(float*)(ws + WS_TMP), modl + 6144 + 5 * 1024};
                pg8::gemm_phase<EpiPartial, CtxSplit, true, true>(lds, gc, Sc, Ec);
            }
#if REP_G4 > 1
            { EpiResid Ez{X, (const float*)(ws + WS_ZERO), (const float*)(ws + WS_ZERO), (const float*)X}; pg8::gemm_phase<EpiResid, pg8::StaticOrder, true, true>(lds, g, S, Ez); }
#endif
        } PH_END
    }
    PH_BEGIN final_norm(a); PH_END
#undef PH_BEGIN
#undef PH_END
}

extern "C" void kernel_launch(void* const* d_in, const int* in_sizes, int n_in, void* d_out, int out_size, void* d_ws, size_t ws_size, hipStream_t stream) {
    static int grid = 0;
    if (grid == 0) {
        if (n_in != 19 || in_sizes[0] != SEQ * D || out_size != SEQ * D || ws_size < WS_END) { fprintf(stderr, "kernel_launch: unexpected shapes (n_in %d, x %d, out %d, ws %zu)\n", n_in, n_in > 0 ? in_sizes[0] : -1, out_size, ws_size); grid = -1; return; }
        int dev = 0, cus = 0, per_cu = 0;
        hipGetDevice(&dev); hipDeviceGetAttribute(&cus, hipDeviceAttributeMultiprocessorCount, dev);
        if (hipFuncSetAttribute((const void*)mega_fwd, hipFuncAttributeMaxDynamicSharedMemorySize, LDS_BYTES) != hipSuccess) { fprintf(stderr, "kernel_launch: hipFuncSetAttribute failed\n"); grid = -1; return; }
        if (hipOccupancyMaxActiveBlocksPerMultiprocessor(&per_cu, (const void*)mega_fwd, NTHR, LDS_BYTES) != hipSuccess || per_cu < 1) { fprintf(stderr, "kernel_launch: occupancy query says %d\n", per_cu); per_cu = 1; }
        (void)hipGetLastError();
        grid = cus * 1;
    }
    if (grid < 0) return;
    if (hipMemsetAsync((char*)d_ws + WS_BAR, 0, BAR_ZERO_BYTES, stream) != hipSuccess) { fprintf(stderr, "kernel_launch: memset of barrier words failed\n"); return; }
    Args a{};
    for (int i = 0; i < 19; ++i) a.in[i] = (const float*)d_in[i];
    a.out = (float*)d_out; a.ws = (unsigned char*)d_ws;
#if MK_SPLIT
    for (int p = 0; p < N_PHASES; ++p) { a.ph_lo = p; a.ph_hi = p + 1; hipLaunchKernelGGL(mega_fwd, dim3(grid), dim3(NTHR), LDS_BYTES, stream, a); }
#else
    a.ph_lo = 0; a.ph_hi = N_PHASES;
    void* args[] = {&a};
    hipError_t e = hipLaunchCooperativeKernel((const void*)mega_fwd, dim3(grid), dim3(NTHR), args, LDS_BYTES, stream);
    if (e != hipSuccess) fprintf(stderr, "cooperative launch failed: %s (grid %d)\n", hipGetErrorString(e), grid);
#endif
}
```
